# Optimizing an MI355X kernel written in HIP

```python
import jax, jax.numpy as jnp
from jax import lax
import numpy as np

D_MODEL = 1024
BATCH = 4
SEQ = 4096
DEPTH = 2
DEC_BATCH = 2
DEC_SEQ = 16384
PAST_LEN = 128

MIX_WIDTH = 768
N_MEM = 256
X_HEADS = 4
X_HEAD_DIM = 64
X_WIDTH = X_HEADS * X_HEAD_DIM
HG_EXPAND = 128
HG_HEADS = MIX_WIDTH // HG_EXPAND
HG_DV = MIX_WIDTH // HG_HEADS
HG_CHUNK = 64
HEAD_DIM = 64
N_Q_HEADS = MIX_WIDTH // HEAD_DIM
N_KV_HEADS = 4
GROUP = N_Q_HEADS // N_KV_HEADS
KV_WIDTH = N_KV_HEADS * HEAD_DIM
WINDOW = 128
BLOCK = 128
ROPE_THETA = 10000.0
D_FF = 2816
CONV_W = 3
EPS = 1e-6
N_A = (DEPTH + 1) // 2
N_B = DEPTH // 2
HG_IN = 5 * MIX_WIDTH + X_WIDTH
GQA_IN = MIX_WIDTH + 2 * KV_WIDTH + X_WIDTH
OUT_IN = MIX_WIDTH + X_WIDTH

kernel_name = "hybrid_hgrn2_swa_mem_encoder"

F32 = jnp.float32


def rmsnorm(x, w):
    xf = x.astype(F32)
    y = xf * lax.rsqrt(jnp.mean(xf * xf, axis=-1, keepdims=True) + EPS)
    return (y * w.astype(F32)).astype(x.dtype)


def rope(x, pos):
    hd = x.shape[-1]
    freqs = ROPE_THETA ** (-jnp.arange(0, hd, 2, dtype=F32) / hd)
    ang = pos[:, None] * freqs[None, :]
    cos = jnp.cos(ang)[None, :, None, :]
    sin = jnp.sin(ang)[None, :, None, :]
    xf = x.astype(F32)
    x1, x2 = xf[..., : hd // 2], xf[..., hd // 2:]
    return jnp.concatenate([x1 * cos - x2 * sin, x2 * cos + x1 * sin], axis=-1).astype(x.dtype)


def gla_chunked(q, k, v, g):
    B, S, H, dk = q.shape
    dv = v.shape[-1]
    C = HG_CHUNK
    N = S // C
    q, k, g = (t.reshape(B, N, C, H, dk) for t in (q, k, g))
    v = v.reshape(B, N, C, H, dv)
    b = jnp.cumsum(g, axis=2)
    b_last = b[:, :, -1:]
    q_t = q * jnp.exp(b)
    k_t = k * jnp.exp(-b)
    k_end = k * jnp.exp(b_last - b)
    scores = jnp.einsum('bnchd,bnshd->bnhcs', q_t, k_t)
    causal_in_chunk = jnp.tril(jnp.ones((C, C), dtype=bool))
    scores = jnp.where(causal_in_chunk, scores, 0.0)
    o_intra = jnp.einsum('bnhcs,bnshv->bnchv', scores, v)
    decay = jnp.exp(b_last[:, :, 0])

    def step(state, xs):
        qn, kn, vn, dn = xs
        o = jnp.einsum('bchd,bhdv->bchv', qn, state)
        state = dn[..., None] * state + jnp.einsum('bchd,bchv->bhdv', kn, vn)
        return state, o

    xs = (jnp.moveaxis(q_t, 1, 0), jnp.moveaxis(k_end, 1, 0),
          jnp.moveaxis(v, 1, 0), jnp.moveaxis(decay, 1, 0))
    s0 = jnp.zeros((B, H, dk, dv), F32)
    _, o_inter = lax.scan(step, s0, xs)
    o = o_intra + jnp.moveaxis(o_inter, 0, 1)
    return o.reshape(B, S, H, dv)


def hgrn2_mixer(cols, lb_fwd, lb_bwd, gn_w):
    B, S, _ = cols.shape
    q_raw, f_fw, f_bw, i_in, g_out = jnp.split(cols, 5, axis=-1)
    heads = lambda t: t.reshape(B, S, HG_HEADS, -1)
    q = heads(jax.nn.silu(q_raw.astype(F32)))
    v = heads(i_in.astype(F32))

    def gates(f_raw, lb):
        lb = lb.astype(F32)
        f = lb + (1.0 - lb) * jax.nn.sigmoid(f_raw.astype(F32))
        return heads(1.0 - f), heads(jnp.log(f))

    k_f, g_f = gates(f_fw, lb_fwd)
    k_b, g_b = gates(f_bw, lb_bwd)
    o_f = gla_chunked(q, k_f, v, g_f)
    rev = lambda t: jnp.flip(t, axis=1)
    o_b = rev(gla_chunked(rev(q), rev(k_b), rev(v), rev(g_b)))
    o = (o_f + o_b).reshape(B, S, MIX_WIDTH)
    o = rmsnorm(o, gn_w) * jax.nn.silu(g_out.astype(F32))
    return o.astype(cols.dtype)


def window_attn(q, k, v, sink):
    B, S, Hkv, G, hd = q.shape
    nb = S // BLOCK
    pad = ((0, 0), (BLOCK, BLOCK), (0, 0), (0, 0))
    kp = jnp.pad(k.astype(F32), pad).reshape(B, nb + 2, BLOCK, Hkv, hd)
    vp = jnp.pad(v.astype(F32), pad).reshape(B, nb + 2, BLOCK, Hkv, hd)
    kw = jnp.concatenate([kp[:, :-2], kp[:, 1:-1], kp[:, 2:]], axis=2)
    vw = jnp.concatenate([vp[:, :-2], vp[:, 1:-1], vp[:, 2:]], axis=2)
    qb = q.astype(F32).reshape(B, nb, BLOCK, Hkv, G, hd)
    s = jnp.einsum('bnqhgd,bnkhd->bnhgqk', qb, kw) * (hd ** -0.5)
    qi = jnp.arange(BLOCK)[:, None]
    kj = jnp.arange(3 * BLOCK)[None, :]
    band = jnp.abs(kj - BLOCK - qi) <= WINDOW
    kpos = jnp.arange(nb)[:, None] * BLOCK - BLOCK + jnp.arange(3 * BLOCK)[None, :]
    in_seq = (kpos >= 0) & (kpos < S)
    mask = band[None] & in_seq[:, None, :]
    s = jnp.where(mask[None, :, None, None], s, -jnp.inf)
    sk = sink.astype(F32).reshape(Hkv, G)[None, None, :, :, None, None]
    m = jnp.maximum(jnp.max(s, axis=-1, keepdims=True), sk)
    p = jnp.exp(s - m)
    denom = jnp.sum(p, axis=-1, keepdims=True) + jnp.exp(sk - m)
    o = jnp.einsum('bnhgqk,bnkhd->bnqhgd', p / denom, vw)
    return o.reshape(B, S, Hkv * G * hd).astype(q.dtype)


def mem_attn(q, k, v):
    s = jnp.einsum('bshd,bmhd->bhsm', q.astype(F32), k.astype(F32)) * (q.shape[-1] ** -0.5)
    p = jax.nn.softmax(s, axis=-1)
    o = jnp.einsum('bhsm,bmhd->bshd', p, v.astype(F32))
    return o.astype(q.dtype)


def conv_glu(h, w_up, conv_w, conv_b, w_down):
    u = h @ w_up
    up = jnp.pad(u, ((0, 0), (1, 1), (0, 0)))
    c = up[:, :-2] * conv_w[0] + up[:, 1:-1] * conv_w[1] + up[:, 2:] * conv_w[2] + conv_b
    gate, val = jnp.split(c, 2, axis=-1)
    return (jax.nn.silu(gate) * val) @ w_down


def trunk(x, mem, norm_mix, norm_mem, norm_ffn, hg_w_in, hg_lb, hg_gn,
          gq_w_in, gq_qn, gq_kn, gq_sink, x_w_kv, x_qn, x_kn, w_out,
          ffn_w_up, ffn_conv_w, ffn_conv_b, ffn_w_down):
    B, S, _ = x.shape
    pos = jnp.arange(S, dtype=F32)
    lb_all = jnp.cumsum(jax.nn.softmax(hg_lb.astype(F32), axis=1), axis=1)
    for i in range(DEPTH):
        h = rmsnorm(x, norm_mix[i])
        mem_h = rmsnorm(mem, norm_mem[i])
        kv = (mem_h @ x_w_kv[i]).reshape(B, N_MEM, 2, X_HEADS, X_HEAD_DIM)
        mk = rmsnorm(kv[:, :, 0], x_kn[i])
        mv = kv[:, :, 1]
        if i % 2 == 0:
            a = i // 2
            cols = h @ hg_w_in[a]
            mix_out = hgrn2_mixer(cols[..., : 5 * MIX_WIDTH], lb_all[0, i], lb_all[1, i], hg_gn[a])
            xq = cols[..., 5 * MIX_WIDTH:]
        else:
            b = i // 2
            cols = h @ gq_w_in[b]
            q = cols[..., :MIX_WIDTH].reshape(B, S, N_Q_HEADS, HEAD_DIM)
            k = cols[..., MIX_WIDTH: MIX_WIDTH + KV_WIDTH].reshape(B, S, N_KV_HEADS, HEAD_DIM)
            v = cols[..., MIX_WIDTH + KV_WIDTH: MIX_WIDTH + 2 * KV_WIDTH].reshape(B, S, N_KV_HEADS, HEAD_DIM)
            xq = cols[..., MIX_WIDTH + 2 * KV_WIDTH:]
            q = rope(rmsnorm(q, gq_qn[b]), pos).reshape(B, S, N_KV_HEADS, GROUP, HEAD_DIM)
            k = rope(rmsnorm(k, gq_kn[b]), pos)
            mix_out = window_attn(q, k, v, gq_sink[b])
        xq = rmsnorm(xq.reshape(B, S, X_HEADS, X_HEAD_DIM), x_qn[i])
        x_out = mem_attn(xq, mk, mv).reshape(B, S, X_WIDTH)
        x = x + jnp.concatenate([mix_out, x_out], axis=-1) @ w_out[i]
        h2 = rmsnorm(x, norm_ffn[i])
        x = x + conv_glu(h2, ffn_w_up[i], ffn_conv_w[i], ffn_conv_b[i], ffn_w_down[i])
    return x


def setup_inputs(seed: int = 0) -> dict:
    key = jax.random.key(seed)
    ks = jax.random.split(key, 24)
    nrm = lambda k, shape, s: jax.random.normal(k, shape, F32) * s
    gain = lambda k, shape: 1.0 + 0.02 * jax.random.normal(k, shape, F32)
    D = D_MODEL
    return {
        "x_prompt": nrm(ks[0], (BATCH, SEQ, D), 1.0),
        "x_sample": nrm(ks[1], (DEC_BATCH, DEC_SEQ, D), 1.0),
        "mem_prompt": nrm(ks[2], (BATCH, N_MEM, D), 1.0),
        "mem_sample": nrm(ks[3], (DEC_BATCH, N_MEM, D), 1.0),
        "norm_mix": gain(ks[4], (DEPTH, D)),
        "norm_mem": gain(ks[5], (DEPTH, D)),
        "norm_ffn": gain(ks[6], (DEPTH, D)),
        "hg_w_in": nrm(ks[7], (N_A, D, HG_IN), D ** -0.5),
        "hg_lb": nrm(ks[8], (2, DEPTH + 1, MIX_WIDTH), 0.5),
        "hg_gn": gain(ks[9], (N_A, MIX_WIDTH)),
        "gq_w_in": nrm(ks[10], (N_B, D, GQA_IN), D ** -0.5),
        "gq_qn": gain(ks[11], (N_B, HEAD_DIM)),
        "gq_kn": gain(ks[12], (N_B, HEAD_DIM)),
        "gq_sink": nrm(ks[13], (N_B, N_Q_HEADS), 0.5),
        "x_w_kv": nrm(ks[14], (DEPTH, D, 2 * X_WIDTH), D ** -0.5),
        "x_qn": gain(ks[15], (DEPTH, X_HEAD_DIM)),
        "x_kn": gain(ks[16], (DEPTH, X_HEAD_DIM)),
        "w_out": nrm(ks[17], (DEPTH, OUT_IN, D), OUT_IN ** -0.5),
        "ffn_w_up": nrm(ks[18], (DEPTH, D, 2 * D_FF), D ** -0.5),
        "ffn_conv_w": nrm(ks[19], (DEPTH, CONV_W, 2 * D_FF), CONV_W ** -0.5),
        "ffn_conv_b": nrm(ks[20], (DEPTH, 2 * D_FF), 0.02),
        "ffn_w_down": nrm(ks[21], (DEPTH, D_FF, D), D_FF ** -0.5),
    }


def reference(x_prompt, x_sample, mem_prompt, mem_sample, norm_mix, norm_mem, norm_ffn,
              hg_w_in, hg_lb, hg_gn, gq_w_in, gq_qn, gq_kn, gq_sink, x_w_kv, x_qn, x_kn,
              w_out, ffn_w_up, ffn_conv_w, ffn_conv_b, ffn_w_down):
    y_prompt = trunk(x_prompt, mem_prompt, norm_mix, norm_mem, norm_ffn, hg_w_in, hg_lb, hg_gn,
                     gq_w_in, gq_qn, gq_kn, gq_sink, x_w_kv, x_qn, x_kn, w_out,
                     ffn_w_up, ffn_conv_w, ffn_conv_b, ffn_w_down)
    y_sample = trunk(x_sample, mem_sample, norm_mix, norm_mem, norm_ffn, hg_w_in, hg_lb, hg_gn,
                     gq_w_in, gq_qn, gq_kn, gq_sink, x_w_kv, x_qn, x_kn, w_out,
                     ffn_w_up, ffn_conv_w, ffn_conv_b, ffn_w_down)
    return (y_prompt, y_sample)
```

```cpp
#include <hip/hip_runtime.h>
#include <hip/hip_cooperative_groups.h>
#include <cstdio>
#include <cstdint>
namespace cg = cooperative_groups;

#define DI __device__ __forceinline__
#define LAS __attribute__((address_space(3)))
typedef unsigned short bf16_t;
typedef short bf16x8 __attribute__((ext_vector_type(8)));
typedef short s16x4 __attribute__((ext_vector_type(4)));
typedef float f32x4 __attribute__((ext_vector_type(4)));
typedef float f32x16 __attribute__((ext_vector_type(16)));
typedef unsigned u32x4 __attribute__((ext_vector_type(4)));
typedef unsigned u32x2 __attribute__((ext_vector_type(2)));
typedef __bf16 bf16v2 __attribute__((ext_vector_type(2)));

constexpr int T = 49152, TP = 16384, D = 1024, MIX = 768, XW = 256, DFF = 2816, MROWS = 1536;
constexpr float EPS = 1e-6f;
constexpr float LOG2E = 1.4426950408889634f;
constexpr float QSCALE = 0.125f * LOG2E;
constexpr int NUP_TILES = 194;

constexpr size_t MiB = 1u << 20;
constexpr size_t WS_WHG = 0, WS_WGQ = 8 * MiB, WS_WKV = 11 * MiB, WS_WOUT = 13 * MiB, WS_WUP = 17 * MiB, WS_WDN = 39 * MiB;
constexpr size_t WS_SSQ = 50 * MiB, WS_SSQM = 53 * MiB, WS_MEMB = 54 * MiB, WS_MK = 57 * MiB, WS_MVT = 59 * MiB;
constexpr size_t WS_ROPEC = 61 * MiB, WS_ROPES = 63 * MiB, WS_LB = 65 * MiB, WS_DEC = 66 * MiB;
constexpr size_t WS_XB = 69 * MiB;
constexpr size_t WS_US = WS_XB;
constexpr size_t WS_XQ = 166 * MiB;
constexpr size_t WS_R = 190 * MiB;
constexpr size_t WS_QH = WS_R, WS_VT = WS_R + 72 * MiB, WS_GT = WS_R + 144 * MiB, WS_MIXA = WS_R + 144 * MiB;
constexpr size_t WS_ACT = WS_R;
constexpr size_t WS_Q1 = WS_R, WS_K1 = WS_R + 72 * MiB, WS_VT1 = WS_R + 96 * MiB;
constexpr size_t WS_GO2 = 478 * MiB;
constexpr size_t WS_END = 502 * MiB;
constexpr size_t WS_SMALL = 67 * MiB + 512 * 1024;
constexpr int SM_XQN = 0, SM_XKN = 128, SM_GQQN = 256, SM_GQKN = 320, SM_SINK = 384, SM_HGGN = 512, SM_CONVW = 2048, SM_CONVB = 36864, SM_BND = 400  , SM_END = 48128;
#define B_WHG ((bf16_t*)(ws + WS_WHG))
#define B_WGQ ((bf16_t*)(ws + WS_WGQ))
#define B_WKV ((bf16_t*)(ws + WS_WKV))
#define B_WOUT ((bf16_t*)(ws + WS_WOUT))
#define B_WUP ((bf16_t*)(ws + WS_WUP))
#define B_WDN ((bf16_t*)(ws + WS_WDN))
#define B_SSQ ((float*)(ws + WS_SSQ))
#define B_SSQM ((float*)(ws + WS_SSQM))
#define B_MEMB ((bf16_t*)(ws + WS_MEMB))
#define B_MK ((bf16_t*)(ws + WS_MK))
#define B_MVT ((bf16_t*)(ws + WS_MVT))
#define B_ROPEC ((float*)(ws + WS_ROPEC))
#define B_ROPES ((float*)(ws + WS_ROPES))
#define B_LB ((float*)(ws + WS_LB))
#define B_DEC ((float*)(ws + WS_DEC))
#define B_XB ((bf16_t*)(ws + WS_XB))
#define B_US ((bf16_t*)(ws + WS_US))
#define B_XQ ((bf16_t*)(ws + WS_XQ))
#define B_QH ((bf16_t*)(ws + WS_QH))
#define B_VT ((bf16_t*)(ws + WS_VT))
#define B_GT ((bf16_t*)(ws + WS_GT))
#define B_MIXA ((bf16_t*)(ws + WS_MIXA))
#define B_ACT ((bf16_t*)(ws + WS_ACT))
#define B_Q1 ((bf16_t*)(ws + WS_Q1))
#define B_K1 ((bf16_t*)(ws + WS_K1))
#define B_VT1 ((bf16_t*)(ws + WS_VT1))
#define B_GO2 ((bf16_t*)(ws + WS_GO2))
#define B_SMALL ((float*)(ws + WS_SMALL))
#define B_OF ((bf16_t*)out)
#define B_OB ((bf16_t*)out + (size_t)T * 768)
#define B_GO1 ((bf16_t*)out + (size_t)2 * T * 768)

constexpr int LDS_BYTES = 147456;
constexpr int HALO_OFF = 131072;

DI float bf2f(short s) { return __uint_as_float(((unsigned)(unsigned short)s) << 16); }
DI unsigned pk2(float a, float b) { bf16v2 v; v.x = (__bf16)a; v.y = (__bf16)b; return __builtin_bit_cast(unsigned, v); }
DI bf16_t f2bf(float a) { __bf16 v = (__bf16)a; return __builtin_bit_cast(unsigned short, v); }
DI bf16x8 mk8(float a0, float a1, float a2, float a3, float a4, float a5, float a6, float a7) {
    u32x4 p; p.x = pk2(a0, a1); p.y = pk2(a2, a3); p.z = pk2(a4, a5); p.w = pk2(a6, a7); return __builtin_bit_cast(bf16x8, p); }
template <int S> DI bf16x8 pack8(const f32x16& x) { return mk8(x[8 * S], x[8 * S + 1], x[8 * S + 2], x[8 * S + 3], x[8 * S + 4], x[8 * S + 5], x[8 * S + 6], x[8 * S + 7]); }
DI bf16x8 ld_frag2(const bf16_t* p) { const s16x4 lo = *(const s16x4*)p; const s16x4 hi = *(const s16x4*)(p + 8); return __builtin_shufflevector(lo, hi, 0, 1, 2, 3, 4, 5, 6, 7); }
DI int crow(int reg, int h) { return (reg & 3) + 8 * (reg >> 2) + 4 * h; }
DI float ex2(float x) { return __builtin_amdgcn_exp2f(x); }
DI float rcpf(float x) { return __builtin_amdgcn_rcpf(x); }
DI float siluf(float x) { return x * rcpf(1.0f + ex2(-x * LOG2E)); }
DI float wave_sum(float v) {
#pragma unroll
    for (int o = 1; o < 64; o <<= 1) v += __shfl_xor(v, o);
    return v; }
DI int seq_start(int r) { return r < TP ? (r & ~4095) : TP + ((r - TP) & ~16383); }
DI int seq_end(int r) { return r < TP ? (r & ~4095) + 4096 : TP + ((r - TP) & ~16383) + 16384; }
DI int seq_of(int r) { return r < TP ? (r >> 12) : 4 + ((r - TP) >> 14); }
DI bool is_seq_start(int r) { return r < TP ? ((r & 4095) == 0) : (((r - TP) & 16383) == 0); }
#define MFMA32(a, b, c) __builtin_amdgcn_mfma_f32_32x32x16_bf16((a), (b), (c), 0, 0, 0)
#define LDS_WAIT() asm volatile("s_waitcnt lgkmcnt(0)" ::: "memory")

struct Params {
    const float *x_prompt, *x_sample, *mem_prompt, *mem_sample, *norm_mix, *norm_mem, *norm_ffn, *hg_w_in, *hg_lb, *hg_gn, *gq_w_in,
                *gq_qn, *gq_kn, *gq_sink, *x_w_kv, *x_qn, *x_kn, *w_out, *ffn_w_up, *ffn_conv_w, *ffn_conv_b, *ffn_w_down;
    float* out; unsigned char* ws;
};

namespace pg8 {
#define PG8_LAS __attribute__((address_space(3)))
typedef unsigned short bf16_t;
typedef short bf16x8 __attribute__((ext_vector_type(8)));
typedef float f32x4 __attribute__((ext_vector_type(4)));
typedef unsigned u32x4 __attribute__((ext_vector_type(4)));
constexpr int BM = 256, BK = 64, HALF = 128, HTB = HALF * BK * 2  , STAGE_BYTES = 8 * HTB, NXCD = 8, WGM = 8;

__host__ __device__ __forceinline__ int lds_byte(int r, int c) { const int st = (r >> 4) * 2 + (c >> 5), rr = r & 15, cc = c & 31, ob = rr * 64 + cc * 2; return st * 1024 + (ob ^ (((ob >> 9) & 1) << 5)); }
__host__ __device__ __forceinline__ void stage_rc(int b, int& R, int& C) { const int st = b / 1024, sb = b % 1024, swz = sb ^ (((sb >> 9) & 1) << 5); R = (st >> 1) * 16 + swz / 64; C = (st & 1) * 32 + (swz % 64) / 2; }
__host__ __device__ __forceinline__ int perm32(int rho) { const int n = rho >> 4, i = rho & 15; return 8 * (i >> 2) + 4 * n + (i & 3); }

struct Unit { int pm, pn; };
struct Gemm { const bf16_t* A; const bf16_t* Bt; int M, N, K; int rs, r0; };

struct StaticOrder {
    int nM, nN, nwg, G, c;
    __host__ __device__ void init(int nM_, int nN_, int G_, int c_) { nM = nM_; nN = nN_; nwg = nM * nN; G = G_; c = c_; }
    __host__ __device__ bool next(int i, Unit& u) const {
        const long L = (long)i * G + c; if (L >= nwg) return false;
        int wgid = (int)L; { const int q = nwg / NXCD, r = nwg % NXCD, xcd = wgid % NXCD, off = wgid / NXCD; wgid = (xcd < r ? xcd * (q + 1) : r * (q + 1) + (xcd - r) * q) + off; }
        const int nig = WGM * nN, gid = wgid / nig, fm = gid * WGM, gsz = (nM - fm) < WGM ? (nM - fm) : WGM;
        u.pm = fm + ((wgid % nig) % gsz); u.pn = (wgid % nig) / gsz; return true;
    }
    __device__ __forceinline__ void a_ready(const Unit&) const {}
    __device__ __forceinline__ void done(const Unit&) const {}
};

__device__ __forceinline__ unsigned cvt_pk_bf16(float lo, float hi) { unsigned r; asm volatile("v_cvt_pk_bf16_f32 %0, %1, %2" : "=v"(r) : "v"(lo), "v"(hi)); return r; }
template <class Epi, class Sched, bool ALIGN_EPI = false, bool SP2 = false>
__device__ __forceinline__ void gemm_phase(PG8_LAS unsigned char* lds, const Gemm g, const Sched& S, const Epi& E) {
    int tid_o = threadIdx.x; asm volatile("" : "+v"(tid_o)); const int tid = tid_o, wid = __builtin_amdgcn_readfirstlane(tid >> 6), lane = tid & 63, wr = wid >> 2, wc = wid & 3, fr = lane & 15, fq = lane >> 4;
    const int K = g.K, nt = K / BK;
    unsigned voffA[2], voffB[2];
#pragma unroll
    for (int i = 0; i < 2; ++i) { int R, C; stage_rc(tid * 16 + i * 8192, R, C); const int Rb = Epi::PERM ? ((R & ~31) + perm32(R & 31)) : R;
        const int Ra = (R & 64) + 4 * (R & 15) + ((R >> 4) & 3); voffA[i] = (unsigned)(Ra * K + C) * 2u;     voffB[i] = (unsigned)(Rb * K + C) * 2u; }
    const size_t kstep = (size_t)(BK * 2);
    const size_t hstep = (size_t)HALF * K * 2;
    const size_t tstep = 2 * hstep;
    const unsigned ldsw = (unsigned)wid * 1024u;
    const int aoff = lds_byte(wr * 64 + fr, fq * 8), boff = lds_byte(wc * 32 + fr, fq * 8);
#define PG8_SA(b, h) (((b) * 2 + (h)) * HTB)
#define PG8_SB(b, h) ((4 + (b) * 2 + (h)) * HTB)
#define PG8_STAGE(bufoff, gbase, voff) do { _Pragma("unroll") for (int _i = 0; _i < 2; ++_i) \
        __builtin_amdgcn_global_load_lds((const unsigned*)((const char*)(gbase) + (voff)[_i]), (PG8_LAS unsigned*)(lds + (bufoff) + ldsw + _i * 8192), 16, 0, 0); } while (0)
#define PG8_LDA(dst, b, h) do { _Pragma("unroll") for (int m = 0; m < 4; ++m) _Pragma("unroll") for (int k = 0; k < 2; ++k) dst[m][k] = *(const PG8_LAS bf16x8*)(lds + PG8_SA(b, h) + aoff + m * 2048 + k * 1024); } while (0)
#define PG8_LDB(dst, b, h) do { _Pragma("unroll") for (int n = 0; n < 2; ++n) _Pragma("unroll") for (int k = 0; k < 2; ++k) dst[n][k] = *(const PG8_LAS bf16x8*)(lds + PG8_SB(b, h) + boff + n * 2048 + k * 1024); } while (0)
#define PG8_MMA(ai, bj, At, Bt) do { __builtin_amdgcn_s_setprio(1); _Pragma("unroll") for (int m = 0; m < 4; ++m) _Pragma("unroll") for (int n = 0; n < 2; ++n) _Pragma("unroll") for (int k = 0; k < 2; ++k) \
        acc[ai][bj][m][n] = __builtin_amdgcn_mfma_f32_16x16x32_bf16(Bt[n][k], At[m][k], acc[ai][bj][m][n], 0, 0, 0); __builtin_amdgcn_s_setprio(0); } while (0)
#define PG8_WAIT_V(n) asm volatile("s_waitcnt vmcnt(" #n ")" ::: "memory")
#define PG8_WAIT_L(n) asm volatile("s_waitcnt lgkmcnt(" #n ")" ::: "memory")
#define PG8_BAR __builtin_amdgcn_s_barrier()
#define PG8_SCHED __builtin_amdgcn_sched_barrier(0)
    Unit cur, nxt; int ui = 0;
    if (!S.next(0, cur)) return;
    f32x4 acc[2][2][4][2];
#pragma unroll
    for (int a = 0; a < 2; ++a)
#pragma unroll
        for (int b = 0; b < 2; ++b)
#pragma unroll
            for (int m = 0; m < 4; ++m)
#pragma unroll
                for (int n = 0; n < 2; ++n) acc[a][b][m][n] = (f32x4){0.f, 0.f, 0.f, 0.f};
    bf16x8 At[4][2], B0[2][2], B1[2][2];
    const char* cA = (const char*)g.A + ((long)cur.pm * g.rs + g.r0) * (long)(K * 2); const char* cB = (const char*)g.Bt + (size_t)cur.pn * tstep;
    S.a_ready(cur);
    if constexpr (SP2) {
        PG8_STAGE(PG8_SB(0, 0), cB, voffB); PG8_STAGE(PG8_SB(0, 1), cB + hstep, voffB); PG8_STAGE(PG8_SA(0, 0), cA, voffA); PG8_STAGE(PG8_SA(0, 1), cA + hstep, voffA);
        if (wr == 1) PG8_BAR;
        PG8_WAIT_V(2); PG8_BAR;
        PG8_STAGE(PG8_SB(1, 0), cB + kstep, voffB); PG8_STAGE(PG8_SA(1, 0), cA + kstep, voffA); PG8_STAGE(PG8_SB(1, 1), cB + hstep + kstep, voffB);
        PG8_WAIT_V(6); PG8_BAR;
    } else {
        PG8_STAGE(PG8_SB(0, 0), cB, voffB); PG8_STAGE(PG8_SA(0, 0), cA, voffA); PG8_STAGE(PG8_SB(0, 1), cB + hstep, voffB); PG8_STAGE(PG8_SA(0, 1), cA + hstep, voffA);
        if (wr == 1) PG8_BAR;
        PG8_WAIT_V(4); PG8_BAR;
        PG8_STAGE(PG8_SB(1, 0), cB + kstep, voffB); PG8_STAGE(PG8_SA(1, 0), cA + kstep, voffA); PG8_STAGE(PG8_SB(1, 1), cB + hstep + kstep, voffB);
        PG8_WAIT_V(6); PG8_BAR;
    }
    for (;;) {
        const bool has_next = S.next(ui + 1, nxt);
        const char* nA = has_next ? (const char*)g.A + ((long)nxt.pm * g.rs + g.r0) * (long)(K * 2) : cA; const char* nB = has_next ? (const char*)g.Bt + (size_t)nxt.pn * tstep : cB;
        for (int t = 0; t < nt; t += 2) {
            const bool last = (t == nt - 2);
            const char* a1 = cA + (size_t)(t + 1) * kstep;
            const char* a2 = last ? nA : cA + (size_t)(t + 2) * kstep; const char* b2 = last ? nB : cB + (size_t)(t + 2) * kstep;
            const char* a3 = a2 + kstep; const char* b3 = b2 + kstep;
            if (last && has_next) S.a_ready(nxt);
            if constexpr (SP2) {
            PG8_LDB(B0, 0, 0); PG8_LDB(B1, 0, 1); PG8_SCHED; PG8_LDA(At, 0, 0); PG8_STAGE(PG8_SA(1, 1), a1 + hstep, voffA);
            PG8_WAIT_V(8); PG8_WAIT_L(0); PG8_BAR; PG8_MMA(0, 0, At, B0); PG8_MMA(0, 1, At, B1); PG8_BAR; PG8_SCHED;
            PG8_LDA(At, 0, 1); PG8_STAGE(PG8_SB(0, 0), b2, voffB); PG8_STAGE(PG8_SB(0, 1), b2 + hstep, voffB); PG8_STAGE(PG8_SA(0, 0), a2, voffA);
            PG8_WAIT_V(8); PG8_WAIT_L(0); PG8_BAR; PG8_MMA(1, 0, At, B0); PG8_MMA(1, 1, At, B1); PG8_BAR; PG8_SCHED;
            PG8_LDB(B0, 1, 0); PG8_LDB(B1, 1, 1); PG8_SCHED; PG8_LDA(At, 1, 0); PG8_STAGE(PG8_SA(0, 1), a2 + hstep, voffA);
            PG8_WAIT_V(8); PG8_WAIT_L(0); PG8_BAR; PG8_MMA(0, 0, At, B0); PG8_MMA(0, 1, At, B1); PG8_BAR; PG8_SCHED;
            PG8_LDA(At, 1, 1); PG8_STAGE(PG8_SB(1, 0), b3, voffB); PG8_STAGE(PG8_SB(1, 1), b3 + hstep, voffB); PG8_STAGE(PG8_SA(1, 0), a3, voffA);
            PG8_WAIT_V(8); PG8_WAIT_L(0); PG8_BAR; PG8_MMA(1, 0, At, B0); PG8_MMA(1, 1, At, B1); PG8_BAR; PG8_SCHED;
            } else {
            PG8_LDB(B0, 0, 0); PG8_SCHED; PG8_LDA(At, 0, 0); PG8_STAGE(PG8_SA(1, 1), a1 + hstep, voffA);
            PG8_WAIT_L(8); PG8_BAR; PG8_WAIT_L(0); PG8_MMA(0, 0, At, B0); PG8_BAR; PG8_SCHED;
            PG8_LDB(B1, 0, 1); PG8_STAGE(PG8_SB(0, 0), b2, voffB);
            PG8_BAR; PG8_WAIT_L(0); PG8_MMA(0, 1, At, B1); PG8_BAR;
            PG8_LDA(At, 0, 1); PG8_STAGE(PG8_SA(0, 0), a2, voffA);
            PG8_BAR; PG8_WAIT_L(0); PG8_MMA(1, 0, At, B0); PG8_BAR; PG8_SCHED;
            PG8_STAGE(PG8_SB(0, 1), b2 + hstep, voffB);
            PG8_WAIT_V(6); PG8_BAR; PG8_MMA(1, 1, At, B1); PG8_BAR;
            PG8_LDB(B0, 1, 0); PG8_SCHED; PG8_LDA(At, 1, 0); PG8_STAGE(PG8_SA(0, 1), a2 + hstep, voffA);
            PG8_WAIT_L(8); PG8_BAR; PG8_WAIT_L(0); PG8_MMA(0, 0, At, B0); PG8_BAR; PG8_SCHED;
            PG8_LDB(B1, 1, 1); PG8_STAGE(PG8_SB(1, 0), b3, voffB);
            PG8_BAR; PG8_WAIT_L(0); PG8_MMA(0, 1, At, B1); PG8_BAR;
            PG8_LDA(At, 1, 1); PG8_STAGE(PG8_SA(1, 0), a3, voffA);
            PG8_BAR; PG8_WAIT_L(0); PG8_MMA(1, 0, At, B0); PG8_BAR; PG8_SCHED;
            PG8_STAGE(PG8_SB(1, 1), b3 + hstep, voffB);
            PG8_WAIT_V(6); PG8_BAR; PG8_MMA(1, 1, At, B1); PG8_BAR;
            }
        }
        if constexpr (ALIGN_EPI) { if (wr == 0) PG8_BAR; }
        if constexpr (!Epi::AFTER_DRAIN) { E(acc, cur, wr, wc, fr, fq); S.done(cur); }
        if (!has_next) break;
#pragma unroll
        for (int a = 0; a < 2; ++a)
#pragma unroll
            for (int b = 0; b < 2; ++b)
#pragma unroll
                for (int m = 0; m < 4; ++m)
#pragma unroll
                    for (int n = 0; n < 2; ++n) acc[a][b][m][n] = (f32x4){0.f, 0.f, 0.f, 0.f};
        cur = nxt; cA = nA; cB = nB; ++ui;
        if constexpr (ALIGN_EPI) { if (wr == 1) PG8_BAR; }
    }
    PG8_WAIT_V(0);
    if constexpr (!ALIGN_EPI) { if (wr == 0) PG8_BAR; }
    PG8_BAR;
    if constexpr (Epi::AFTER_DRAIN) { E.fused(acc, cur, wr, wc, fr, fq, lds, wid, lane); S.done(cur); }
#undef PG8_SA
#undef PG8_SB
#undef PG8_STAGE
#undef PG8_LDA
#undef PG8_LDB
#undef PG8_MMA
#undef PG8_WAIT_V
#undef PG8_WAIT_L
#undef PG8_BAR
#undef PG8_SCHED
}
}

#define PG8_SP2 true
#define PG8_ALIGN true

DI float rstd16(const float* p) {
    const f32x4 a = ((const f32x4*)p)[0], b = ((const f32x4*)p)[1], c = ((const f32x4*)p)[2], d = ((const f32x4*)p)[3];
    const float s = ((a.x + a.y) + (a.z + a.w)) + ((b.x + b.y) + (b.z + b.w)) + ((c.x + c.y) + (c.z + c.w)) + ((d.x + d.y) + (d.z + d.w));
    return __builtin_amdgcn_rsqf(s * (1.0f / 1024.0f) + EPS);
}
DI float rstd4(const float* p) { const f32x4 a = *(const f32x4*)p; return __builtin_amdgcn_rsqf(((a.x + a.y) + (a.z + a.w)) * (1.0f / 1024.0f) + EPS); }
DI float sumsq4(const f32x4 a) { return (a.x * a.x + a.y * a.y) + (a.z * a.z + a.w * a.w); }

template <int CTRL> DI float dppf(float x) { return __builtin_bit_cast(float, __builtin_amdgcn_update_dpp(0, __builtin_bit_cast(int, x), CTRL, 0xf, 0xf, false)); }

enum { EK_KV = 0, EK_HG = 1, EK_GQ = 2, EK_RES = 3, EK_UP = 4 };
template <int KIND> struct EpiAll {
    static constexpr bool PERM = true, AFTER_DRAIN = false;
    unsigned char* ws; float* out; const float *resP, *resS; LAS float* halo; int layer, write_aux;
    DI void operator()(f32x4 (&acc)[2][2][4][2], const pg8::Unit& u, int wr, int wc, int fr, int fq) const {
        if (KIND == EK_HG) run_EpiHg(acc, u, wr, wc, fr, fq);
        else if (KIND == EK_GQ) run_EpiGq(acc, u, wr, wc, fr, fq);
        else if (KIND == EK_RES) run_EpiRes(acc, u, wr, wc, fr, fq);
        else if (KIND == EK_UP) run_EpiUp(acc, u, wr, wc, fr, fq);
        else run_EpiKv(acc, u, wr, wc, fr, fq);
    }
    DI void run_EpiHg(f32x4 (&acc)[2][2][4][2], const pg8::Unit& u, int wr_, int wc_, int fr_, int fq_) const {
        int t_ = threadIdx.x; asm volatile("" : "+v"(t_)); const int wr = t_ >> 8, wc = (t_ >> 6) & 3, fr = t_ & 15, fq = (t_ >> 4) & 3;
        const int kind = u.pn / 3, sub = u.pn - 3 * kind;
        const int cb = sub * 256 + wc * 32 + 8 * fq;
        float lbq[16];
        if (kind == 1 || kind == 2) {
#pragma unroll
            for (int q = 0; q < 16; ++q) lbq[q] = B_LB[(kind - 1) * 768 + cb + (q >> 3) * 128 + (q & 7)];
        }
        float rsa[2][4];
#pragma unroll
        for (int ai = 0; ai < 2; ++ai)
#pragma unroll
        for (int m = 0; m < 4; ++m) rsa[ai][m] = rstd4(B_SSQ + (size_t)(u.pm * 256 + ai * 128 + wr * 64 + 4 * fr + m) * 4);
#pragma unroll
        for (int ai = 0; ai < 2; ++ai) {
            const int r0 = u.pm * 256 + ai * 128 + wr * 64 + 4 * fr;
            float rs[4];
#pragma unroll
            for (int m = 0; m < 4; ++m) rs[m] = rsa[ai][m];
            if (kind == 0 || kind == 4) {
#pragma unroll
                for (int m = 0; m < 4; ++m) {
                    const int r = r0 + m;
                    bf16_t* dst = kind == 0 ? B_QH + (size_t)r * 768 : (r < 32768 ? B_GO1 + (size_t)r * 768 : B_GO2 + (size_t)(r - 32768) * 768);
#pragma unroll
                    for (int bj = 0; bj < 2; ++bj) {
                        const f32x4 a = acc[ai][bj][m][0] * rs[m], b = acc[ai][bj][m][1] * rs[m];
                        u32x4 w;
                        if (kind == 0) { w.x = pk2(siluf(a.x), siluf(a.y)); w.y = pk2(siluf(a.z), siluf(a.w)); w.z = pk2(siluf(b.x), siluf(b.y)); w.w = pk2(siluf(b.z), siluf(b.w)); }
                        else { w.x = pk2(a.x, a.y); w.y = pk2(a.z, a.w); w.z = pk2(b.x, b.y); w.w = pk2(b.z, b.w); }
                        *(u32x4*)(dst + cb + bj * 128) = w;
                    }
                }
            } else if (kind == 1 || kind == 2) {
                const float* lbp = B_LB + (kind - 1) * 768;
                bf16_t* gt = B_GT + (size_t)(kind - 1) * 768 * T + r0;
#pragma unroll
                for (int bj = 0; bj < 2; ++bj)
#pragma unroll
                for (int n = 0; n < 2; ++n)
#pragma unroll
                for (int j = 0; j < 4; ++j) {
                    const int c = cb + bj * 128 + 4 * n + j;
                    const float lbv = lbq[8 * bj + 4 * n + j]; float gv[4];
#pragma unroll
                    for (int m = 0; m < 4; ++m) { const float x = acc[ai][bj][m][n][j] * rs[m]; const float sg = rcpf(1.0f + ex2(-x * LOG2E)); gv[m] = __log2f(lbv + (1.0f - lbv) * sg); }
                    u32x2 w; w.x = pk2(gv[0], gv[1]); w.y = pk2(gv[2], gv[3]);
                    *(u32x2*)(gt + (size_t)c * T) = w;
                }
            } else if (kind == 3) {
                bf16_t* vt = B_VT + r0;
#pragma unroll
                for (int bj = 0; bj < 2; ++bj)
#pragma unroll
                for (int n = 0; n < 2; ++n)
#pragma unroll
                for (int j = 0; j < 4; ++j) {
                    const int c = cb + bj * 128 + 4 * n + j;
                    u32x2 w; w.x = pk2(acc[ai][bj][0][n][j] * rs[0], acc[ai][bj][1][n][j] * rs[1]); w.y = pk2(acc[ai][bj][2][n][j] * rs[2], acc[ai][bj][3][n][j] * rs[3]);
                    *(u32x2*)(vt + (size_t)c * T) = w;
                }
            } else {
#pragma unroll
                for (int m = 0; m < 4; ++m) {
                    const int r = r0 + m;
                    float ss = 0.f;
#pragma unroll
                    for (int bj = 0; bj < 2; ++bj)
#pragma unroll
                    for (int n = 0; n < 2; ++n) ss += sumsq4(acc[ai][bj][m][n]);
                    ss += __shfl_xor(ss, 16); ss += __shfl_xor(ss, 32);
                    const float rn = rs[m] * __builtin_amdgcn_rsqf(ss * rs[m] * rs[m] * (1.0f / 64.0f) + EPS) * QSCALE;
#pragma unroll
                    for (int bj = 0; bj < 2; ++bj) {
                        const f32x4 w0 = *(const f32x4*)(B_SMALL + SM_XQN + 32 * bj + 8 * fq), w1 = *(const f32x4*)(B_SMALL + SM_XQN + 32 * bj + 8 * fq + 4);
                        const f32x4 a = acc[ai][bj][m][0] * w0 * rn, b = acc[ai][bj][m][1] * w1 * rn;
                        u32x4 w; w.x = pk2(a.x, a.y); w.y = pk2(a.z, a.w); w.z = pk2(b.x, b.y); w.w = pk2(b.z, b.w);
                        *(u32x4*)(B_XQ + (size_t)r * 256 + 64 * wc + 32 * bj + 8 * fq) = w;
                    }
                }
            }
            asm volatile("" ::: "memory");
        }
    }
    DI void run_EpiGq(f32x4 (&acc)[2][2][4][2], const pg8::Unit& u, int wr_, int wc_, int fr_, int fq_) const {
        int t_ = threadIdx.x; asm volatile("" : "+v"(t_)); const int wr = t_ >> 8, wc = (t_ >> 6) & 3, fr = t_ & 15, fq = (t_ >> 4) & 3;
        const int pn = u.pn;
        float rsa[2][4];
#pragma unroll
        for (int ai = 0; ai < 2; ++ai)
#pragma unroll
        for (int m = 0; m < 4; ++m) rsa[ai][m] = rstd4(B_SSQ + (size_t)(u.pm * 256 + ai * 128 + wr * 64 + 4 * fr + m) * 4);
#pragma unroll
        for (int ai = 0; ai < 2; ++ai) {
            const int r0 = u.pm * 256 + ai * 128 + wr * 64 + 4 * fr;
            float rs[4];
#pragma unroll
            for (int m = 0; m < 4; ++m) rs[m] = rsa[ai][m];
            if (pn == 4) {
                bf16_t* vt = B_VT1 + r0;
#pragma unroll
                for (int bj = 0; bj < 2; ++bj)
#pragma unroll
                for (int n = 0; n < 2; ++n)
#pragma unroll
                for (int j = 0; j < 4; ++j) {
                    const int c = 64 * wc + 32 * bj + 8 * fq + 4 * n + j;
                    u32x2 w; w.x = pk2(acc[ai][bj][0][n][j] * rs[0], acc[ai][bj][1][n][j] * rs[1]); w.y = pk2(acc[ai][bj][2][n][j] * rs[2], acc[ai][bj][3][n][j] * rs[3]);
                    *(u32x2*)(vt + (size_t)c * T) = w;
                }
            } else {
#pragma unroll
                for (int m = 0; m < 4; ++m) {
                    const int r = r0 + m;
                    float ss = 0.f;
#pragma unroll
                    for (int bj = 0; bj < 2; ++bj)
#pragma unroll
                    for (int n = 0; n < 2; ++n) ss += sumsq4(acc[ai][bj][m][n]);
                    ss += __shfl_xor(ss, 16); ss += __shfl_xor(ss, 32);
                    const float rn = rs[m] * __builtin_amdgcn_rsqf(ss * rs[m] * rs[m] * (1.0f / 64.0f) + EPS);
                    const float* wv = B_SMALL + (pn < 3 ? SM_GQQN : (pn == 3 ? SM_GQKN : SM_XQN + 64));
                    const float sc = (pn == 3) ? 1.0f : QSCALE;
                    bf16_t* dst = pn < 3 ? B_Q1 + (size_t)r * 768 + 64 * (4 * pn + wc) : (pn == 3 ? B_K1 + (size_t)r * 256 + 64 * wc : B_XQ + (size_t)r * 256 + 64 * wc);
                    const int pos = r - seq_start(r);
                    u32x2 k1, k2;
#pragma unroll
                    for (int n = 0; n < 2; ++n) {
                        f32x4 x1 = acc[ai][0][m][n] * rn * *(const f32x4*)(wv + 8 * fq + 4 * n), x2 = acc[ai][1][m][n] * rn * *(const f32x4*)(wv + 32 + 8 * fq + 4 * n);
                        if (pn <= 3) {
                            const f32x4 cs = *(const f32x4*)(B_ROPEC + (size_t)pos * 32 + 8 * fq + 4 * n), sn = *(const f32x4*)(B_ROPES + (size_t)pos * 32 + 8 * fq + 4 * n);
                            const f32x4 t1 = x1 * cs - x2 * sn, t2 = x2 * cs + x1 * sn; x1 = t1; x2 = t2;
                        }
                        x1 = x1 * sc; x2 = x2 * sc;
                        if (n == 0) { k1.x = pk2(x1.x, x1.y); k1.y = pk2(x1.z, x1.w); k2.x = pk2(x2.x, x2.y); k2.y = pk2(x2.z, x2.w); }
                        else {
                            u32x4 w; w.x = k1.x; w.y = k1.y; w.z = pk2(x1.x, x1.y); w.w = pk2(x1.z, x1.w); *(u32x4*)(dst + 8 * fq) = w;
                            w.x = k2.x; w.y = k2.y; w.z = pk2(x2.x, x2.y); w.w = pk2(x2.z, x2.w); *(u32x4*)(dst + 32 + 8 * fq) = w;
                        }
                    }
                    asm volatile("" ::: "memory");
                }
            }
        }
    }
    DI void run_EpiKv(f32x4 (&acc)[2][2][4][2], const pg8::Unit& u, int wr_, int wc_, int fr_, int fq_) const {
        int t_ = threadIdx.x; asm volatile("" : "+v"(t_)); const int wr = t_ >> 8, wc = (t_ >> 6) & 3, fr = t_ & 15, fq = (t_ >> 4) & 3;
        const int layer = u.pn >> 1, isv = u.pn & 1;
#pragma unroll
        for (int ai = 0; ai < 2; ++ai) {
            const int r0 = u.pm * 256 + ai * 128 + wr * 64 + 4 * fr;
            float rs[4];
#pragma unroll
            for (int m = 0; m < 4; ++m) { const f32x4 q4 = *(const f32x4*)(B_SSQM + (size_t)(r0 + m) * 4); rs[m] = __builtin_amdgcn_rsqf(((q4.x + q4.y) + (q4.z + q4.w)) * (1.0f / 1024.0f) + EPS); }
            if (isv) {
                bf16_t* vt = B_MVT + ((size_t)(layer * 6 + (r0 >> 8)) * 256) * 256 + (r0 & 255);
#pragma unroll
                for (int bj = 0; bj < 2; ++bj)
#pragma unroll
                for (int n = 0; n < 2; ++n)
#pragma unroll
                for (int j = 0; j < 4; ++j) {
                    const int c = 64 * wc + 32 * bj + 8 * fq + 4 * n + j;
                    u32x2 w; w.x = pk2(acc[ai][bj][0][n][j] * rs[0], acc[ai][bj][1][n][j] * rs[1]); w.y = pk2(acc[ai][bj][2][n][j] * rs[2], acc[ai][bj][3][n][j] * rs[3]);
                    *(u32x2*)(vt + (size_t)c * 256) = w;
                }
            } else {
#pragma unroll
                for (int m = 0; m < 4; ++m) {
                    const int r = r0 + m;
                    float ss = 0.f;
#pragma unroll
                    for (int bj = 0; bj < 2; ++bj)
#pragma unroll
                    for (int n = 0; n < 2; ++n) ss += sumsq4(acc[ai][bj][m][n]);
                    ss += __shfl_xor(ss, 16); ss += __shfl_xor(ss, 32);
                    const float rn = rs[m] * __builtin_amdgcn_rsqf(ss * rs[m] * rs[m] * (1.0f / 64.0f) + EPS);
                    const float* wv = B_SMALL + SM_XKN + 64 * layer;
#pragma unroll
                    for (int bj = 0; bj < 2; ++bj) {
                        const f32x4 a = acc[ai][bj][m][0] * rn * *(const f32x4*)(wv + 32 * bj + 8 * fq), b = acc[ai][bj][m][1] * rn * *(const f32x4*)(wv + 32 * bj + 8 * fq + 4);
                        u32x4 w; w.x = pk2(a.x, a.y); w.y = pk2(a.z, a.w); w.z = pk2(b.x, b.y); w.w = pk2(b.z, b.w);
                        *(u32x4*)(B_MK + ((size_t)layer * MROWS + r) * 256 + 64 * wc + 32 * bj + 8 * fq) = w;
                    }
                }
            }
        }
    }
    DI void run_EpiRes(f32x4 (&acc)[2][2][4][2], const pg8::Unit& u, int wr_, int wc_, int fr_, int fq_) const {
        int t_ = threadIdx.x; asm volatile("" : "+v"(t_)); const int wr = t_ >> 8, wc = (t_ >> 6) & 3, fr = t_ & 15, fq = (t_ >> 4) & 3;
#pragma unroll
        for (int ai = 0; ai < 2; ++ai)
#pragma unroll
        for (int mp = 0; mp < 2; ++mp) {
            f32x4 rv[2][2][2];
#pragma unroll
            for (int mm = 0; mm < 2; ++mm) {
                const int r = u.pm * 256 + ai * 128 + wr * 64 + 4 * fr + 2 * mp + mm;
                const float* res = r < TP ? resP + (size_t)r * D : resS + (size_t)(r - TP) * D;
#pragma unroll
                for (int bj = 0; bj < 2; ++bj)
#pragma unroll
                for (int n = 0; n < 2; ++n) rv[mm][bj][n] = *(const f32x4*)(res + u.pn * 256 + bj * 128 + wc * 32 + 8 * fq + 4 * n);
            }
#pragma unroll
            for (int mm = 0; mm < 2; ++mm) {
                const int m = 2 * mp + mm;
                const int r = u.pm * 256 + ai * 128 + wr * 64 + 4 * fr + m;
                float ss = 0.f;
#pragma unroll
                for (int bj = 0; bj < 2; ++bj) {
                    const int c = u.pn * 256 + bj * 128 + wc * 32 + 8 * fq;
                    const f32x4 x0 = rv[mm][bj][0] + acc[ai][bj][m][0], x1 = rv[mm][bj][1] + acc[ai][bj][m][1];
                    *(f32x4*)(out + (size_t)r * D + c) = x0; *(f32x4*)(out + (size_t)r * D + c + 4) = x1;
                    ss += sumsq4(x0) + sumsq4(x1);
                    if (write_aux) { u32x4 w; w.x = pk2(x0.x, x0.y); w.y = pk2(x0.z, x0.w); w.z = pk2(x1.x, x1.y); w.w = pk2(x1.z, x1.w); *(u32x4*)(B_XB + (size_t)r * D + c) = w; }
                }
                ss += __shfl_xor(ss, 16); ss += __shfl_xor(ss, 32);
                if (write_aux && fq == 0) halo[(ai * 128 + wr * 64 + 4 * fr + m) * 4 + wc] = ss;
            }
            asm volatile("" ::: "memory");
        }
        if (write_aux) {
            asm volatile("s_waitcnt lgkmcnt(0)" ::: "memory"); __builtin_amdgcn_s_barrier(); asm volatile("" ::: "memory");
            if (t_ < 256) { const f32x4 q = *(const LAS f32x4*)(halo + t_ * 4); B_SSQ[(size_t)(u.pm * 256 + t_) * 4 + u.pn] = (q.x + q.y) + (q.z + q.w); }
            asm volatile("s_waitcnt lgkmcnt(0)" ::: "memory"); __builtin_amdgcn_s_barrier(); asm volatile("" ::: "memory");
        }
    }
    DI void run_EpiUp(f32x4 (&acc)[2][2][4][2], const pg8::Unit& u, int wr_, int wc_, int fr_, int fq_) const {
        int t_ = threadIdx.x; asm volatile("" : "+v"(t_)); const int wr = t_ >> 8, wc = (t_ >> 6) & 3, fr = t_ & 15, fq = (t_ >> 4) & 3;
        const int slot = wc * 32 + 8 * fq;
        const int g0r = u.pm * 254 - 1;
        const bool hasb = (g0r < 0) || ((g0r + 255) >= T) || (g0r < TP ? (((g0r + 256) & ~4095) > g0r) : ((((g0r - TP) + 256) & ~16383) > (g0r - TP)));
#pragma unroll
        for (int ai = 0; ai < 2; ++ai)
#pragma unroll
        for (int m = 0; m < 4; ++m) {
            const int gr = g0r + ai * 128 + wr * 64 + 4 * fr + m;
            const bool ok = gr >= 0 && gr < T;
            const float rs = ok ? rstd4(B_SSQ + (size_t)(ok ? gr : 0) * 4) : 0.f;
#pragma unroll
            for (int bj = 0; bj < 2; ++bj)
#pragma unroll
            for (int n = 0; n < 2; ++n) acc[ai][bj][m][n] = acc[ai][bj][m][n] * rs;
        }
#pragma unroll
        for (int ai = 0; ai < 2; ++ai) {
            const int b = 2 * ai + wr;
#pragma unroll
            for (int bj = 0; bj < 2; ++bj)
#pragma unroll
            for (int n = 0; n < 2; ++n) {
                if (fr == 0) *(LAS f32x4*)(halo + (0 * 4 + b) * 256 + bj * 128 + slot + 4 * n) = acc[ai][bj][0][n];
                if (fr == 15) *(LAS f32x4*)(halo + (1 * 4 + b) * 256 + bj * 128 + slot + 4 * n) = acc[ai][bj][3][n];
            }
        }
        asm volatile("s_waitcnt lgkmcnt(0)" ::: "memory"); __builtin_amdgcn_s_barrier(); asm volatile("" ::: "memory");
        const float* cw = B_SMALL + SM_CONVW + layer * 3 * 5632; const float* cb = B_SMALL + SM_CONVB + layer * 5632;
        u32x2 keep[2][4];
#pragma unroll
        for (int n = 0; n < 2; ++n) {
            const int ch = u.pn * 128 + slot + 4 * n;
            f32x4 w0[2], w1[2], w2[2], wb[2];
            w0[0] = *(const f32x4*)(cw + ch); w1[0] = *(const f32x4*)(cw + 2 * DFF + ch); w2[0] = *(const f32x4*)(cw + 4 * DFF + ch); wb[0] = *(const f32x4*)(cb + ch);
            w0[1] = *(const f32x4*)(cw + DFF + ch); w1[1] = *(const f32x4*)(cw + 3 * DFF + ch); w2[1] = *(const f32x4*)(cw + 5 * DFF + ch); wb[1] = *(const f32x4*)(cb + DFF + ch);
#pragma unroll
            for (int ai = 0; ai < 2; ++ai) {
                const int b = 2 * ai + wr;
                f32x4 upe[2], dne[2];
#pragma unroll
                for (int bj = 0; bj < 2; ++bj) {
                    const f32x4 hprev = (b > 0) ? *(const LAS f32x4*)(halo + (1 * 4 + (b > 0 ? b - 1 : 0)) * 256 + bj * 128 + slot + 4 * n) : (f32x4){0.f, 0.f, 0.f, 0.f};
                    const f32x4 hnext = (b < 3) ? *(const LAS f32x4*)(halo + (0 * 4 + (b < 3 ? b + 1 : 3)) * 256 + bj * 128 + slot + 4 * n) : (f32x4){0.f, 0.f, 0.f, 0.f};
#pragma unroll
                    for (int j = 0; j < 4; ++j) {
                        { const float t = dppf<0x121>(acc[ai][bj][3][n][j]); upe[bj][j] = fr > 0 ? t : hprev[j]; }
                        { const float t = dppf<0x12F>(acc[ai][bj][0][n][j]); dne[bj][j] = fr < 15 ? t : hnext[j]; }
                    }
                }
#pragma unroll
                for (int m = 0; m < 4; ++m) {
                    const int lr = ai * 128 + wr * 64 + 4 * fr + m, gr = g0r + lr;
                    f32x4 gv[2];
#pragma unroll
                    for (int bj = 0; bj < 2; ++bj) {
                        f32x4 up = m > 0 ? acc[ai][bj][m > 0 ? m - 1 : 0][n] : upe[bj];
                        f32x4 dn = m < 3 ? acc[ai][bj][m < 3 ? m + 1 : 3][n] : dne[bj];
                        if (hasb) {
                            if (is_seq_start(gr)) up = (f32x4){0.f, 0.f, 0.f, 0.f};
                            if (is_seq_start(gr + 1)) dn = (f32x4){0.f, 0.f, 0.f, 0.f};
                        }
                        gv[bj] = w0[bj] * up + (w1[bj] * acc[ai][bj][m][n] + (w2[bj] * dn + wb[bj]));
                    }
                    const f32x4 g = gv[0], v = gv[1];
                    u32x2 w; w.x = pk2(siluf(g.x) * v.x, siluf(g.y) * v.y); w.y = pk2(siluf(g.z) * v.z, siluf(g.w) * v.w);
                    if (n == 0) { keep[ai][m] = w; asm volatile("" : "+v"(keep[ai][m].x), "+v"(keep[ai][m].y)); }
                    else if (lr >= 1 && lr <= 254 && gr < T) {
                        u32x4 w4; w4.x = keep[ai][m].x; w4.y = keep[ai][m].y; w4.z = w.x; w4.w = w.y;
                        *(u32x4*)(B_ACT + (size_t)gr * DFF + ch - 4) = w4;
                    }
                }
            }
        }
        asm volatile("s_waitcnt lgkmcnt(0)" ::: "memory"); __builtin_amdgcn_s_barrier(); asm volatile("" ::: "memory");
    }
};

__device__ const double ROPE_FREQ[32] = {1.0, 0.7498942093324559, 0.5623413251903491, 0.4216965034285822, 0.31622776601683794, 0.23713737056616552, 0.1778279410038923, 0.1333521432163324,
    0.1, 0.07498942093324558, 0.05623413251903491, 0.042169650342858224, 0.03162277660168379, 0.023713737056616554, 0.01778279410038923, 0.01333521432163324,
    0.01, 0.007498942093324558, 0.005623413251903491, 0.004216965034285823, 0.0031622776601683794, 0.0023713737056616554, 0.0017782794100389228, 0.001333521432163324,
    0.001, 0.0007498942093324559, 0.0005623413251903491, 0.00042169650342858224, 0.00031622776601683794, 0.00023713737056616554, 0.00017782794100389227, 0.0001333521432163324};

DI void p0_item(const float* W, int ldw, int src0, const float* kw, int k0, bf16_t* WT, int K, int dst0, LAS float* scr, int lane) {
#pragma unroll 8
    for (int i = 0; i < 32; ++i) { const int kk = 2 * i + (lane >> 5); float w = W[(size_t)(k0 + kk) * ldw + src0 + (lane & 31)]; if (kw) w *= kw[k0 + kk]; scr[kk * 33 + (lane & 31)] = w; }
    LDS_WAIT();
    const int c = lane & 7;
#pragma unroll
    for (int j = 0; j < 4; ++j) { const int n = (lane >> 3) + 8 * j; const LAS float* s = scr + (8 * c) * 33 + n;
        u32x4 o; o.x = pk2(s[0 * 33], s[1 * 33]); o.y = pk2(s[2 * 33], s[3 * 33]); o.z = pk2(s[4 * 33], s[5 * 33]); o.w = pk2(s[6 * 33], s[7 * 33]);
        *(u32x4*)(WT + (size_t)(dst0 + n) * K + k0 + 8 * c) = o; }
    LDS_WAIT();
}
DI int headsrc(int w) { return 64 * (w & 3) + 32 * (w >> 2); }
DI void p0_row(const float* xrow, bf16_t* orow, float* ssq, int nssq, int lane) {
    const f32x4* xr = (const f32x4*)xrow + lane; f32x4 v[4]; float s = 0.f;
#pragma unroll
    for (int j = 0; j < 4; ++j) { v[j] = xr[64 * j]; s += sumsq4(v[j]); }
    s = wave_sum(s);
    u32x2* o = (u32x2*)orow + lane;
#pragma unroll
    for (int j = 0; j < 4; ++j) { u32x2 w; w.x = pk2(v[j].x, v[j].y); w.y = pk2(v[j].z, v[j].w); o[64 * j] = w; }
    if (lane < nssq) ssq[lane] = lane == 0 ? s : 0.f;
}

template <bool OUT>
DI void gla_item(const bf16_t* QH, const bf16_t* GT, const bf16_t* VT, bf16_t* US, float* DEC, bf16_t* Odst, int bc, int hd, int dir, int vs, int lane) {
    const int c31 = lane & 31, h = lane >> 5;
    bf16x8 Mf[2], If[2], ONE;
#pragma unroll
    for (int s2 = 0; s2 < 2; ++s2)
#pragma unroll
    for (int jj = 0; jj < 8; ++jj) {
        const int tau = 16 * s2 + 8 * (jj >> 2) + 4 * h + (jj & 3);
        const bool mm = dir ? (tau >= c31) : (tau <= c31);
        Mf[s2][jj] = mm ? (short)0x3F80 : (short)0; If[s2][jj] = (tau == c31) ? (short)0x3F80 : (short)0;
    }
#pragma unroll
    for (int jj = 0; jj < 8; ++jj) ONE[jj] = (short)0x3F80;
    const size_t item = (size_t)(((bc * 6 + hd) * 2 + dir) * 4 + vs);
    bf16_t* dump = US + item * 4096 + lane;
    f32x16 S[4]; float dectot[4] = {0.f, 0.f, 0.f, 0.f};
#pragma unroll
    for (int dt = 0; dt < 4; ++dt)
#pragma unroll
    for (int rg = 0; rg < 16; ++rg) S[dt][rg] = OUT ? bf2f((short)dump[(dt * 16 + rg) * 64]) : 0.f;
    const bf16_t* gtb = GT + (size_t)(dir * 768 + hd * 128 + c31) * T;
    const bf16_t* vtb = VT + (size_t)(hd * 128 + vs * 32 + c31) * T;
    f32x16 zero;
#pragma unroll
    for (int rg = 0; rg < 16; ++rg) zero[rg] = 0.f;
    for (int si = 0; si < 8; ++si) {
        const int sub = dir ? 7 - si : si, tok0 = bc * 256 + sub * 32;
        bf16x8 vf[2];
#pragma unroll
        for (int s2 = 0; s2 < 2; ++s2) vf[s2] = ld_frag2(vtb + tok0 + 16 * s2 + 4 * h);
        if (OUT) {
            f32x16 sc = zero; bf16x8 qt[4][2];
#pragma unroll
            for (int dt = 0; dt < 4; ++dt) {
                bf16x8 gf[2];
#pragma unroll
                for (int s2 = 0; s2 < 2; ++s2) gf[s2] = ld_frag2(gtb + (size_t)dt * 32 * T + tok0 + 16 * s2 + 4 * h);
                f32x16 bT = zero, gT = zero;
#pragma unroll
                for (int s2 = 0; s2 < 2; ++s2) { bT = MFMA32(gf[s2], Mf[s2], bT); gT = MFMA32(gf[s2], If[s2], gT); }
                const bf16_t* qp = QH + (size_t)(tok0 + c31) * 768 + hd * 128 + dt * 32 + 4 * h;
#pragma unroll
                for (int s2 = 0; s2 < 2; ++s2) {
                    const bf16x8 qv = ld_frag2(qp + 16 * s2);
                    float qq[8], kk[8];
#pragma unroll
                    for (int jj = 0; jj < 8; ++jj) {
                        const float b = fmaxf(bT[8 * s2 + jj], -80.f), e = ex2(b);
                        qq[jj] = bf2f(qv[jj]) * e;
                        kk[jj] = (1.0f - ex2(gT[8 * s2 + jj])) * ex2(-b);
                    }
                    qt[dt][s2] = mk8(qq[0], qq[1], qq[2], qq[3], qq[4], qq[5], qq[6], qq[7]);
                    const bf16x8 kt = mk8(kk[0], kk[1], kk[2], kk[3], kk[4], kk[5], kk[6], kk[7]);
                    sc = MFMA32(kt, qt[dt][s2], sc);
                }
            }
#pragma unroll
            for (int rg = 0; rg < 16; ++rg) { const int s = crow(rg, h); const bool keep = dir ? (s >= c31) : (s <= c31); sc[rg] = keep ? sc[rg] : 0.f; }
            f32x16 o = zero;
            o = MFMA32(pack8<0>(sc), vf[0], o); o = MFMA32(pack8<1>(sc), vf[1], o);
#pragma unroll
            for (int dt = 0; dt < 4; ++dt) { o = MFMA32(qt[dt][0], pack8<0>(S[dt]), o); o = MFMA32(qt[dt][1], pack8<1>(S[dt]), o); }
            bf16_t* op = Odst + (size_t)tok0 * 768 + hd * 128 + vs * 32 + c31;
#pragma unroll
            for (int rg = 0; rg < 16; ++rg) op[(size_t)crow(rg, h) * 768] = f2bf(o[rg]);
        }
#pragma unroll
        for (int dt = 0; dt < 4; ++dt) {
            bf16x8 gf[2];
#pragma unroll
            for (int s2 = 0; s2 < 2; ++s2) gf[s2] = ld_frag2(gtb + (size_t)dt * 32 * T + tok0 + 16 * s2 + 4 * h);
            f32x16 bD = zero, tD = zero, dr = zero;
#pragma unroll
            for (int s2 = 0; s2 < 2; ++s2) { bD = MFMA32(Mf[s2], gf[s2], bD); tD = MFMA32(ONE, gf[s2], tD); dr = MFMA32(gf[s2], ONE, dr); }
            const float tot = tD[0];
            if (!OUT) dectot[dt] += tot;
#pragma unroll
            for (int rg = 0; rg < 16; ++rg) S[dt][rg] *= ex2(dr[rg]);
            {
                float ke[8];
#pragma unroll
                for (int jj = 0; jj < 8; ++jj) ke[jj] = (1.0f - ex2(bf2f(gf[0][jj]))) * ex2(tot - bD[jj]);
                S[dt] = MFMA32(mk8(ke[0], ke[1], ke[2], ke[3], ke[4], ke[5], ke[6], ke[7]), vf[0], S[dt]);
#pragma unroll
                for (int jj = 0; jj < 8; ++jj) ke[jj] = (1.0f - ex2(bf2f(gf[1][jj]))) * ex2(tot - bD[8 + jj]);
                S[dt] = MFMA32(mk8(ke[0], ke[1], ke[2], ke[3], ke[4], ke[5], ke[6], ke[7]), vf[1], S[dt]);
            }
        }
    }
    if (!OUT) {
#pragma unroll
        for (int dt = 0; dt < 4; ++dt)
#pragma unroll
        for (int rg = 0; rg < 16; ++rg) dump[(dt * 16 + rg) * 64] = f2bf(S[dt][rg]);
        if (vs == 0 && h == 0) {
            float* dp = DEC + (size_t)((bc * 6 + hd) * 2 + dir) * 128 + c31;
#pragma unroll
            for (int dt = 0; dt < 4; ++dt) dp[32 * dt] = dectot[dt];
        }
    }
}

constexpr int GLA_GRP_BYTES = 33 * 1024;
template <bool OUT>
DI void gla_wg(const bf16_t* QH, const bf16_t* GT, const bf16_t* VT, bf16_t* US, float* DEC, bf16_t* OF_, bf16_t* OB_, LAS unsigned char* lds, int wave, int lane) {
    const int c31 = lane & 31, h = lane >> 5, grp = wave >> 2, j = wave & 3, dir = grp;
    bf16x8 Mf[2], If[2], ONE;
#pragma unroll
    for (int s2 = 0; s2 < 2; ++s2)
#pragma unroll
    for (int jj = 0; jj < 8; ++jj) {
        const int tau = 16 * s2 + 8 * (jj >> 2) + 4 * h + (jj & 3);
        const bool mm = dir ? (tau >= c31) : (tau <= c31);
        Mf[s2][jj] = mm ? (short)0x3F80 : (short)0; If[s2][jj] = (tau == c31) ? (short)0x3F80 : (short)0;
    }
#pragma unroll
    for (int jj = 0; jj < 8; ++jj) ONE[jj] = (short)0x3F80;
    f32x16 zero;
#pragma unroll
    for (int rg = 0; rg < 16; ++rg) zero[rg] = 0.f;
    bf16_t* Odst = dir ? OB_ : OF_;
    int par = 0; bool first = true;
    bf16x8 gfn[2], vfn[2], qvn[2];
#pragma unroll
    for (int s2 = 0; s2 < 2; ++s2) { gfn[s2] = ONE; vfn[s2] = ONE; qvn[s2] = ONE; }
    const int G_ = (int)gridDim.x, nfull = 1152 / G_, rem = 1152 % G_, nrounds = nfull + (rem ? 1 : 0);
    const bool split = rem > 0 && rem * 2 == G_;
    for (int rd = 0; rd < nrounds; ++rd) {
        int wi = (int)blockIdx.x + rd * G_; bool active = true;
        if (rd == nfull) { if (split) { wi = nfull * G_ + (int)blockIdx.x % rem; active = (grp == (int)blockIdx.x / rem); } else if (wi >= 1152) break; }
        int wn = -1; bool an = false;
        if (rd + 1 < nrounds) { if (rd + 1 == nfull && split) { wn = nfull * G_ + (int)blockIdx.x % rem; an = (grp == (int)blockIdx.x / rem); } else { wn = (int)blockIdx.x + (rd + 1) * G_; an = wn < 1152; } }
        if (!active) {
            for (int si = 0; si < 8; ++si, par ^= 1) { asm volatile("s_waitcnt lgkmcnt(0)" ::: "memory"); __builtin_amdgcn_s_barrier(); asm volatile("" ::: "memory"); }
            continue;
        }
        const int hd = wi % 6, bc = wi / 6;
        const size_t item = (size_t)(((bc * 6 + hd) * 2 + dir) * 4 + j);
        bf16_t* dump = US + item * 4096 + lane * 64;
        f32x16 S[4]; float dectot = 0.f;
#pragma unroll
        for (int dt = 0; dt < 4; ++dt) {
            if (OUT) {
                const u32x4 lo = *(const u32x4*)(dump + dt * 16), hi = *(const u32x4*)(dump + dt * 16 + 8);
#pragma unroll
                for (int q = 0; q < 4; ++q) { S[dt][2 * q] = __uint_as_float(lo[q] << 16); S[dt][2 * q + 1] = __uint_as_float(lo[q] & 0xffff0000u);
                                              S[dt][8 + 2 * q] = __uint_as_float(hi[q] << 16); S[dt][8 + 2 * q + 1] = __uint_as_float(hi[q] & 0xffff0000u); }
            } else {
#pragma unroll
                for (int rg = 0; rg < 16; ++rg) S[dt][rg] = 0.f;
            }
        }
        const bf16_t* gtb = GT + (size_t)(dir * 768 + hd * 128 + 32 * j + c31) * T;
        const bf16_t* vtb = VT + (size_t)(hd * 128 + 32 * j + c31) * T;
        if (first) {
            const int tokf = bc * 256 + (dir ? 7 : 0) * 32;
#pragma unroll
            for (int s2 = 0; s2 < 2; ++s2) { gfn[s2] = ld_frag2(gtb + tokf + 16 * s2 + 4 * h); vfn[s2] = ld_frag2(vtb + tokf + 16 * s2 + 4 * h);
                if (OUT) qvn[s2] = ld_frag2(QH + (size_t)(tokf + c31) * 768 + hd * 128 + 32 * j + 4 * h + 16 * s2); }
            first = false;
        }
        for (int si = 0; si < 8; ++si, par ^= 1) {
            const int sub = dir ? 7 - si : si, tok0 = bc * 256 + sub * 32;
            bf16x8 gf[2], vf[2], qvv[2];
#pragma unroll
            for (int s2 = 0; s2 < 2; ++s2) { gf[s2] = gfn[s2]; vf[s2] = vfn[s2]; qvv[s2] = qvn[s2]; }
            {
                int bcn = bc, hdn = hd, subn = dir ? 6 - si : si + 1;
                if (si == 7) { if (an) { hdn = wn % 6; bcn = wn / 6; subn = dir ? 7 : 0; } else subn = sub; }
                const int tokn = bcn * 256 + subn * 32;
                const bf16_t* gtn = GT + (size_t)(dir * 768 + hdn * 128 + 32 * j + c31) * T; const bf16_t* vtn = VT + (size_t)(hdn * 128 + 32 * j + c31) * T;
#pragma unroll
                for (int s2 = 0; s2 < 2; ++s2) { gfn[s2] = ld_frag2(gtn + tokn + 16 * s2 + 4 * h); vfn[s2] = ld_frag2(vtn + tokn + 16 * s2 + 4 * h);
                    if (OUT) qvn[s2] = ld_frag2(QH + (size_t)(tokn + c31) * 768 + hdn * 128 + 32 * j + 4 * h + 16 * s2); }
            }
            LAS unsigned char* base = lds + (par * 2 + grp) * GLA_GRP_BYTES;
            LAS bf16x8* QT = (LAS bf16x8*)base; LAS bf16x8* KE = (LAS bf16x8*)(base + 8192); LAS f32x4* SC = (LAS f32x4*)(base + 16384); LAS float* DR = (LAS float*)(base + 32768);
            {
                f32x16 bD = zero, tD = zero;
#pragma unroll
                for (int s2 = 0; s2 < 2; ++s2) { bD = MFMA32(Mf[s2], gf[s2], bD); tD = MFMA32(ONE, gf[s2], tD); }
                const float tot = tD[0];
                dectot += tot;
                if (h == 0) DR[j * 32 + c31] = ex2(tot);
                float ke[8];
#pragma unroll
                for (int jj = 0; jj < 8; ++jj) ke[jj] = (1.0f - ex2(bf2f(gf[0][jj]))) * ex2(tot - bD[jj]);
                KE[(j * 2 + 0) * 64 + lane] = mk8(ke[0], ke[1], ke[2], ke[3], ke[4], ke[5], ke[6], ke[7]);
#pragma unroll
                for (int jj = 0; jj < 8; ++jj) ke[jj] = (1.0f - ex2(bf2f(gf[1][jj]))) * ex2(tot - bD[8 + jj]);
                KE[(j * 2 + 1) * 64 + lane] = mk8(ke[0], ke[1], ke[2], ke[3], ke[4], ke[5], ke[6], ke[7]);
            }
            if (OUT) {
                f32x16 bT = zero, gT = zero, scp = zero;
#pragma unroll
                for (int s2 = 0; s2 < 2; ++s2) { bT = MFMA32(gf[s2], Mf[s2], bT); gT = MFMA32(gf[s2], If[s2], gT); }
#pragma unroll
                for (int s2 = 0; s2 < 2; ++s2) {
                    const bf16x8 qv = qvv[s2];
                    float qq[8], kk[8];
#pragma unroll
                    for (int jj = 0; jj < 8; ++jj) {
                        const float b = fmaxf(bT[8 * s2 + jj], -80.f), e = ex2(b);
                        qq[jj] = bf2f(qv[jj]) * e;
                        kk[jj] = (1.0f - ex2(gT[8 * s2 + jj])) * ex2(-b);
                    }
                    const bf16x8 qt = mk8(qq[0], qq[1], qq[2], qq[3], qq[4], qq[5], qq[6], qq[7]);
                    const bf16x8 kt = mk8(kk[0], kk[1], kk[2], kk[3], kk[4], kk[5], kk[6], kk[7]);
                    QT[(j * 2 + s2) * 64 + lane] = qt;
                    scp = MFMA32(kt, qt, scp);
                }
#pragma unroll
                for (int g4 = 0; g4 < 4; ++g4) SC[(j * 4 + g4) * 64 + lane] = (f32x4){scp[4 * g4], scp[4 * g4 + 1], scp[4 * g4 + 2], scp[4 * g4 + 3]};
            }
            asm volatile("s_waitcnt lgkmcnt(0)" ::: "memory"); __builtin_amdgcn_s_barrier(); asm volatile("" ::: "memory");
            if (OUT) {
                f32x16 sc = zero;
#pragma unroll
                for (int dt = 0; dt < 4; ++dt)
#pragma unroll
                for (int g4 = 0; g4 < 4; ++g4) { const f32x4 t = SC[(dt * 4 + g4) * 64 + lane]; sc[4 * g4] += t.x; sc[4 * g4 + 1] += t.y; sc[4 * g4 + 2] += t.z; sc[4 * g4 + 3] += t.w; }
#pragma unroll
                for (int rg = 0; rg < 16; ++rg) { const int s = crow(rg, h); const bool keep = dir ? (s >= c31) : (s <= c31); sc[rg] = keep ? sc[rg] : 0.f; }
                f32x16 o = zero;
                o = MFMA32(pack8<0>(sc), vf[0], o); o = MFMA32(pack8<1>(sc), vf[1], o);
#pragma unroll
                for (int dt = 0; dt < 4; ++dt) { o = MFMA32(QT[(dt * 2 + 0) * 64 + lane], pack8<0>(S[dt]), o); o = MFMA32(QT[(dt * 2 + 1) * 64 + lane], pack8<1>(S[dt]), o); }
                bf16_t* op = Odst + (size_t)tok0 * 768 + hd * 128 + j * 32 + c31;
#pragma unroll
                for (int rg = 0; rg < 16; ++rg) op[(size_t)crow(rg, h) * 768] = f2bf(o[rg]);
            }
#pragma unroll
            for (int dt = 0; dt < 4; ++dt) {
#pragma unroll
                for (int a = 0; a < 4; ++a) { const f32x4 dv = *(const LAS f32x4*)(DR + dt * 32 + 8 * a + 4 * h); S[dt][4 * a] *= dv.x; S[dt][4 * a + 1] *= dv.y; S[dt][4 * a + 2] *= dv.z; S[dt][4 * a + 3] *= dv.w; }
                S[dt] = MFMA32(KE[(dt * 2 + 0) * 64 + lane], vf[0], S[dt]);
                S[dt] = MFMA32(KE[(dt * 2 + 1) * 64 + lane], vf[1], S[dt]);
            }
        }
        if (!OUT) {
#pragma unroll
            for (int dt = 0; dt < 4; ++dt) {
                u32x4 lo, hi;
#pragma unroll
                for (int q = 0; q < 4; ++q) { lo[q] = pk2(S[dt][2 * q], S[dt][2 * q + 1]); hi[q] = pk2(S[dt][8 + 2 * q], S[dt][8 + 2 * q + 1]); }
                *(u32x4*)(dump + dt * 16) = lo; *(u32x4*)(dump + dt * 16 + 8) = hi;
            }
            if (h == 0) DEC[(size_t)((bc * 6 + hd) * 2 + dir) * 128 + 32 * j + c31] = dectot;
        }
    }
    __syncthreads();
}

DI void gla_scan_item(bf16_t* US, const float* DEC, int chain, int part, int lane) {
    const int vs = chain & 3, dir = (chain >> 2) & 1, hs = chain >> 3, hd = hs % 6, sq = hs / 6;
    const int bc0 = sq < 4 ? 16 * sq : 64 + 64 * (sq - 4), nbc = sq < 4 ? 16 : 64;
    const int L = part * 8 + (lane >> 3), kk = lane & 7, dt = kk >> 1, q = kk & 1, hh = L >> 5;
    const int d0 = 32 * dt + 16 * q + 4 * hh;
    float carry[8];
#pragma unroll
    for (int i = 0; i < 8; ++i) carry[i] = 0.f;
    u32x4 un[4]; f32x4 dan[4], dbn[4];
#pragma unroll
    for (int k = 0; k < 4; ++k) {
        const int bc = bc0 + (dir ? nbc - 1 - k : k);
        const size_t item = (size_t)(((bc * 6 + hd) * 2 + dir) * 4 + vs);
        un[k] = *(const u32x4*)(US + item * 4096 + part * 512 + lane * 8);
        const float* dp = DEC + (size_t)((bc * 6 + hd) * 2 + dir) * 128 + d0;
        dan[k] = *(const f32x4*)dp; dbn[k] = *(const f32x4*)(dp + 8);
    }
    for (int n0 = 0; n0 < nbc; n0 += 4) {
        u32x4 u[4]; f32x4 dla[4], dlb[4];
#pragma unroll
        for (int k = 0; k < 4; ++k) { u[k] = un[k]; dla[k] = dan[k]; dlb[k] = dbn[k]; }
        if (n0 + 4 < nbc) {
#pragma unroll
            for (int k = 0; k < 4; ++k) {
                const int n = n0 + 4 + k, bc = bc0 + (dir ? nbc - 1 - n : n);
                const size_t item = (size_t)(((bc * 6 + hd) * 2 + dir) * 4 + vs);
                un[k] = *(const u32x4*)(US + item * 4096 + part * 512 + lane * 8);
                const float* dp = DEC + (size_t)((bc * 6 + hd) * 2 + dir) * 128 + d0;
                dan[k] = *(const f32x4*)dp; dbn[k] = *(const f32x4*)(dp + 8);
            }
        }
#pragma unroll
        for (int k = 0; k < 4; ++k) {
            const int n = n0 + k, bc = bc0 + (dir ? nbc - 1 - n : n);
            const size_t item = (size_t)(((bc * 6 + hd) * 2 + dir) * 4 + vs);
            u32x4 w; w.x = pk2(carry[0], carry[1]); w.y = pk2(carry[2], carry[3]); w.z = pk2(carry[4], carry[5]); w.w = pk2(carry[6], carry[7]);
            *(u32x4*)(US + item * 4096 + part * 512 + lane * 8) = w;
#pragma unroll
            for (int i = 0; i < 4; ++i) {
                const unsigned x = u[k][i];
                const float de = ex2(i < 2 ? dla[k][2 * i] : dlb[k][2 * (i - 2)]), dod = ex2(i < 2 ? dla[k][2 * i + 1] : dlb[k][2 * (i - 2) + 1]);
                carry[2 * i] = de * carry[2 * i] + __uint_as_float(x << 16);
                carry[2 * i + 1] = dod * carry[2 * i + 1] + __uint_as_float(x & 0xffff0000u);
            }
        }
    }
}

template <bool WIN>
DI void attn_item(const bf16_t* qrow  , const bf16_t* kbase  , int ldk, const bf16_t* vtbase  , size_t ldvt,
                  int q0, int key_lo, int ntiles, int kvalid_lo, int kvalid_hi, float mref, float l0, bf16_t* orow  , int lane) {
    const int c31 = lane & 31, h = lane >> 5;
    bf16x8 qf[4];
#pragma unroll
    for (int s = 0; s < 4; ++s) qf[s] = *(const bf16x8*)(qrow + 16 * s + 8 * h);
    f32x16 O[2];
#pragma unroll
    for (int rg = 0; rg < 16; ++rg) { O[0][rg] = 0.f; O[1][rg] = 0.f; }
    float lrun = (h == 0) ? l0 : 0.f;
    int tlo = 0, thi = ntiles;
    if (WIN) { tlo = kvalid_lo > key_lo ? (kvalid_lo - key_lo) >> 5 : 0; const int e = (kvalid_hi - key_lo) >> 5; thi = e < ntiles ? e : ntiles; }
    for (int ti = tlo; ti < thi; ++ti) {
        const int k0 = key_lo + 32 * ti;
        const bf16_t* kr = kbase + (size_t)(k0 + c31) * ldk + 8 * h;
        f32x16 sc;
#pragma unroll
        for (int rg = 0; rg < 16; ++rg) sc[rg] = -mref;
#pragma unroll
        for (int s = 0; s < 4; ++s) { const bf16x8 kf = *(const bf16x8*)(kr + 16 * s); sc = MFMA32(kf, qf[s], sc); }
        if (WIN && (ti == 0 || ti == ntiles - 1)) {
#pragma unroll
            for (int rg = 0; rg < 16; ++rg) { const int df = (k0 + crow(rg, h)) - (q0 + c31); sc[rg] = (df >= -128 && df <= 128) ? sc[rg] : -1e30f; }
        }
        float ps = 0.f;
#pragma unroll
        for (int rg = 0; rg < 16; ++rg) { sc[rg] = ex2(sc[rg]); ps += sc[rg]; }
        lrun += ps;
        const bf16x8 p0 = pack8<0>(sc), p1 = pack8<1>(sc);
#pragma unroll
        for (int t = 0; t < 2; ++t) {
            const bf16_t* vp = vtbase + (size_t)(32 * t + c31) * ldvt + k0 + 4 * h;
            O[t] = MFMA32(ld_frag2(vp), p0, O[t]);
            O[t] = MFMA32(ld_frag2(vp + 16), p1, O[t]);
        }
    }
    const float linv = rcpf(lrun + __shfl_xor(lrun, 32));
#pragma unroll
    for (int t = 0; t < 2; ++t)
#pragma unroll
    for (int g = 0; g < 4; ++g) {
        u32x2 w; w.x = pk2(O[t][4 * g] * linv, O[t][4 * g + 1] * linv); w.y = pk2(O[t][4 * g + 2] * linv, O[t][4 * g + 3] * linv);
        *(u32x2*)(orow + 32 * t + 8 * g + 4 * h) = w;
    }
}

constexpr int KSTR = 144;
template <bool WIN, int VSTR>
DI void attn_wave_lds(const bf16_t* qrow, const LAS unsigned char* Kl, const LAS unsigned char* Vl, int tlo, int thi, int edge_lo, int edge_hi, int q_local  ,
                      float mref, float l0, bf16_t* orow, int lane) {
    const int c31 = lane & 31, h = lane >> 5;
    bf16x8 qf[4];
#pragma unroll
    for (int s = 0; s < 4; ++s) qf[s] = *(const bf16x8*)(qrow + 16 * s + 8 * h);
    f32x16 O[2];
#pragma unroll
    for (int rg = 0; rg < 16; ++rg) { O[0][rg] = 0.f; O[1][rg] = 0.f; }
    float lrun = (h == 0) ? l0 : 0.f;
#pragma nounroll
    for (int tl = tlo; tl < thi; ++tl) {
        const LAS unsigned char* kr = Kl + (32 * tl + c31) * KSTR + 16 * h;
        f32x16 sc;
#pragma unroll
        for (int rg = 0; rg < 16; ++rg) sc[rg] = -mref;
#pragma unroll
        for (int s = 0; s < 4; ++s) { const bf16x8 kf = *(const LAS bf16x8*)(kr + 32 * s); sc = MFMA32(kf, qf[s], sc); }
        if (WIN && (tl == edge_lo || tl == edge_hi)) {
#pragma unroll
            for (int rg = 0; rg < 16; ++rg) { const int df = (32 * tl + crow(rg, h)) - (q_local + c31); sc[rg] = (df >= -128 && df <= 128) ? sc[rg] : -1e30f; }
        }
        float ps = 0.f;
#pragma unroll
        for (int rg = 0; rg < 16; ++rg) { sc[rg] = ex2(sc[rg]); ps += sc[rg]; }
        lrun += ps;
        const bf16x8 p0 = pack8<0>(sc), p1 = pack8<1>(sc);
#pragma unroll
        for (int t = 0; t < 2; ++t) {
            const LAS unsigned char* vp = Vl + (32 * t + c31) * VSTR + 2 * (32 * tl + 4 * h);
            const s16x4 a0 = *(const LAS s16x4*)(vp), a1 = *(const LAS s16x4*)(vp + 16), b0 = *(const LAS s16x4*)(vp + 32), b1 = *(const LAS s16x4*)(vp + 48);
            O[t] = MFMA32(__builtin_shufflevector(a0, a1, 0, 1, 2, 3, 4, 5, 6, 7), p0, O[t]);
            O[t] = MFMA32(__builtin_shufflevector(b0, b1, 0, 1, 2, 3, 4, 5, 6, 7), p1, O[t]);
        }
    }
    const float linv = rcpf(lrun + __shfl_xor(lrun, 32));
#pragma unroll
    for (int t = 0; t < 2; ++t)
#pragma unroll
    for (int g = 0; g < 4; ++g) {
        u32x2 w; w.x = pk2(O[t][4 * g] * linv, O[t][4 * g + 1] * linv); w.y = pk2(O[t][4 * g + 2] * linv, O[t][4 * g + 3] * linv);
        *(u32x2*)(orow + 32 * t + 8 * g + 4 * h) = w;
    }
}
DI void cross_attn_wg(const bf16_t* XQ, const bf16_t* MKl, const bf16_t* MVTl, bf16_t* MIXA, float mref, LAS unsigned char* lds, int tid, int wave, int lane) {
    constexpr int VS = 520;
    LAS unsigned char* Kl = lds; LAS unsigned char* Vl = lds + 256 * KSTR;
    const int vb_ = (gridDim.x & 7) ? (int)blockIdx.x : (int)((blockIdx.x & 7) * (gridDim.x >> 3) + (blockIdx.x >> 3));
    for (int it = vb_; it < 192 * 4; it += gridDim.x) {
        const int qb = it % 192, hx = it / 192, sq = seq_of(qb * 256);
        asm volatile("s_waitcnt lgkmcnt(0)" ::: "memory"); __builtin_amdgcn_s_barrier(); asm volatile("" ::: "memory");
#pragma unroll
        for (int i = 0; i < 4; ++i) { const int id = tid + 512 * i, row = id >> 3, ch = id & 7;
            *(LAS u32x4*)(Kl + row * KSTR + 16 * ch) = *(const u32x4*)(MKl + ((size_t)sq * 256 + row) * 256 + 64 * hx + 8 * ch); }
#pragma unroll
        for (int i = 0; i < 4; ++i) { const int id = tid + 512 * i, row = id >> 5, ch = id & 31;
            const u32x4 v = *(const u32x4*)(MVTl + ((size_t)sq * 256 + 64 * hx + row) * 256 + 8 * ch);
            *(LAS u32x2*)(Vl + row * VS + 16 * ch) = (u32x2){v.x, v.y}; *(LAS u32x2*)(Vl + row * VS + 16 * ch + 8) = (u32x2){v.z, v.w}; }
        asm volatile("s_waitcnt lgkmcnt(0)" ::: "memory"); __builtin_amdgcn_s_barrier(); asm volatile("" ::: "memory");
        const int q0 = qb * 256 + 32 * wave, c31 = lane & 31;
        attn_wave_lds<false, VS>(XQ + (size_t)(q0 + c31) * 256 + 64 * hx, Kl, Vl, 0, 8, -1, -1, 0, mref, 0.f, MIXA + (size_t)(q0 + c31) * D + MIX + 64 * hx, lane);
    }
    __syncthreads();
}
DI void win_attn_wg(const bf16_t* Q1, const bf16_t* K1, const bf16_t* VT1, const float* sm, bf16_t* MIXA, LAS unsigned char* lds, int tid, int wave, int lane) {
    constexpr int VS = 1032;
    LAS unsigned char* Kl = lds; LAS unsigned char* Vl = lds + 512 * KSTR;
    const int vb_ = (gridDim.x & 7) ? (int)blockIdx.x : (int)((blockIdx.x & 7) * (gridDim.x >> 3) + (blockIdx.x >> 3));
    for (int it = vb_; it < 192 * 4; it += gridDim.x) {
        const int qb = it % 192, kvh = it / 192, q0b = qb * 256, key0 = q0b - 128, s0 = seq_start(q0b), s1 = seq_end(q0b);
        asm volatile("s_waitcnt lgkmcnt(0)" ::: "memory"); __builtin_amdgcn_s_barrier(); asm volatile("" ::: "memory");
#pragma unroll 4
        for (int i = 0; i < 8; ++i) { const int id = tid + 512 * i, row = id >> 3, ch = id & 7, key = key0 + row;
            if (key >= s0 && key < s1) *(LAS u32x4*)(Kl + row * KSTR + 16 * ch) = *(const u32x4*)(K1 + (size_t)key * 256 + 64 * kvh + 8 * ch); }
#pragma unroll 4
        for (int i = 0; i < 8; ++i) { const int id = tid + 512 * i, row = id >> 6, ch = id & 63, key = key0 + 8 * ch;
            if (key >= s0 && key < s1) { const u32x4 v = *(const u32x4*)(VT1 + (size_t)(64 * kvh + row) * T + key);
                *(LAS u32x2*)(Vl + row * VS + 16 * ch) = (u32x2){v.x, v.y}; *(LAS u32x2*)(Vl + row * VS + 16 * ch + 8) = (u32x2){v.z, v.w}; } }
        asm volatile("s_waitcnt lgkmcnt(0)" ::: "memory"); __builtin_amdgcn_s_barrier(); asm volatile("" ::: "memory");
        const int q0 = q0b + 32 * wave, c31 = lane & 31;
        int tlo = wave, thi = wave + 9;
        { const int lo = (s0 - key0) >> 5; if (s0 > key0 && lo > tlo) tlo = lo; const int hi = (s1 - key0) >> 5; if (hi < thi) thi = hi; }
#pragma unroll 1
        for (int g = 0; g < 3; ++g) {
            const int qh = 3 * kvh + g; const float sk2 = sm[SM_SINK + qh] * LOG2E, mrefw = fmaxf(sm[SM_BND + 2], sk2);
            attn_wave_lds<true, VS>(Q1 + (size_t)(q0 + c31) * 768 + 64 * qh, Kl, Vl, tlo, thi, wave, wave + 8, 128 + 32 * wave, mrefw, ex2(sk2 - mrefw), MIXA + (size_t)(q0 + c31) * D + 64 * qh, lane);
        }
    }
    __syncthreads();
}

DI void cross_attn_items(const bf16_t* XQ, const bf16_t* MKl, const bf16_t* MVTl, bf16_t* MIXA, float mref, int gw, int NGW, int lane) {
    for (int it = gw; it < 1536 * 4; it += NGW) {
        const int qt = it >> 2, hx = it & 3, q0 = qt * 32, sq = seq_of(q0), c31 = lane & 31;
        attn_item<false>(XQ + (size_t)(q0 + c31) * 256 + 64 * hx, MKl + (size_t)sq * 256 * 256 + 64 * hx, 256, MVTl + ((size_t)sq * 256 + 64 * hx) * 256, 256,
                         q0, 0, 8, 0, 256, mref, 0.f, MIXA + (size_t)(q0 + c31) * D + MIX + 64 * hx, lane);
    }
}

#define KPRE \
    int tid_ = threadIdx.x; asm volatile("" : "+v"(tid_)); const int tid = tid_, lane = tid & 63, wave = __builtin_amdgcn_readfirstlane(tid >> 6); \
    const int G = gridDim.x, gw = wave * G + blockIdx.x, NGW = G * 8; (void)lane; (void)gw; (void)NGW; (void)G; (void)tid;

DI void b_p0(const Params& P, LAS unsigned char* lds) {
    KPRE
    unsigned char* ws = P.ws;
    {
        LAS float* scr = (LAS float*)(lds + wave * 16384);
        for (int it = gw; it < 12800; it += NGW) {
            int r = it;
            if (r < 2048) { const int kb = r >> 7, g = r & 127; const int src = g < 120 ? 32 * g : 3840 + headsrc(g - 120);
                p0_item(P.hg_w_in, 4096, src, P.norm_mix, 64 * kb, B_WHG, 1024, 32 * g, scr, lane); continue; } r -= 2048;
            if (r < 768) { const int kb = r / 48, g = r % 48; const int src = 256 * (g >> 3) + headsrc(g & 7);
                p0_item(P.gq_w_in, 1536, src, P.norm_mix + 1024, 64 * kb, B_WGQ, 1024, 32 * g, scr, lane); continue; } r -= 768;
            if (r < 512) { const int kb = r >> 5, g = r & 31, pn = g >> 3, layer = pn >> 1, kv = pn & 1; const int src = 256 * kv + headsrc(g & 7);
                p0_item(P.x_w_kv + (size_t)layer * 1024 * 512, 512, src, P.norm_mem + 1024 * layer, 64 * kb, B_WKV, 1024, 32 * g, scr, lane); continue; } r -= 512;
            if (r < 1024) { const int l = r >> 9, q = r & 511, kb = q >> 5, g = q & 31;
                p0_item(P.w_out + (size_t)l * 1024 * 1024, 1024, 32 * g, nullptr, 64 * kb, B_WOUT + (size_t)l * 1024 * 1024, 1024, 32 * g, scr, lane); continue; } r -= 1024;
            if (r < 5632) { const int l = r / 2816, q = r % 2816, kb = q / 176, g = q % 176, pn = g >> 3, w = g & 7; const int src = (w >> 2) * DFF + 128 * pn + 32 * (w & 3);
                p0_item(P.ffn_w_up + (size_t)l * 1024 * 5632, 5632, src, P.norm_ffn + 1024 * l, 64 * kb, B_WUP + (size_t)l * 5632 * 1024, 1024, 32 * g, scr, lane); continue; } r -= 5632;
            { const int l = r / 1408, q = r % 1408, kb = q >> 5, g = q & 31;
                p0_item(P.ffn_w_down + (size_t)l * DFF * 1024, 1024, 32 * g, nullptr, 64 * kb, B_WDN + (size_t)l * 1024 * DFF, DFF, 32 * g, scr, lane); }
        }
        for (int m = gw; m < T + MROWS; m += NGW) {
            if (m < T) p0_row(m < TP ? P.x_prompt + (size_t)m * D : P.x_sample + (size_t)(m - TP) * D, B_XB + (size_t)m * D, B_SSQ + (size_t)m * 4, 4, lane);
            else { const int q = m - T; p0_row(q < 1024 ? P.mem_prompt + (size_t)q * D : P.mem_sample + (size_t)(q - 1024) * D, B_MEMB + (size_t)q * D, B_SSQM + (size_t)q * 4, 4, lane); }
        }
        for (int i = blockIdx.x * 512 + tid; i < 16384 * 32; i += G * 512) {
            const int pos = i >> 5, f = i & 31;
            const double rev = (double)pos * ROPE_FREQ[f] * 0.15915494309189535;
            const float fr = (float)(rev - __builtin_rint(rev));
            B_ROPEC[i] = __builtin_amdgcn_cosf(fr); B_ROPES[i] = __builtin_amdgcn_sinf(fr);
        }
        for (int i = blockIdx.x * 512 + tid; i < SM_END; i += G * 512) {
            float v = 0.f;
            if (i < SM_XKN) v = P.x_qn[i];
            else if (i < SM_GQQN) v = P.x_kn[i - SM_XKN];
            else if (i < SM_GQKN) v = P.gq_qn[i - SM_GQQN];
            else if (i < SM_SINK) v = P.gq_kn[i - SM_GQKN];
            else if (i < SM_SINK + 12) v = P.gq_sink[i - SM_SINK];
            else if (i >= SM_BND && i < SM_BND + 3) {
                const float* wq = i == SM_BND + 2 ? P.gq_qn : P.x_qn + 64 * (i - SM_BND); const float* wk = i == SM_BND + 2 ? P.gq_kn : P.x_kn + 64 * (i - SM_BND);
                float mq = 0.f, mk = 0.f;
                for (int e = 0; e < 64; ++e) { mq = fmaxf(mq, fabsf(wq[e])); mk = fmaxf(mk, fabsf(wk[e])); }
                v = 8.0f * LOG2E * mq * mk;
            }
            else if (i >= SM_HGGN && i < SM_HGGN + 768) v = P.hg_gn[i - SM_HGGN];
            else if (i >= SM_CONVW && i < SM_CONVW + 2 * 3 * 5632) v = P.ffn_conv_w[i - SM_CONVW];
            else if (i >= SM_CONVB && i < SM_CONVB + 2 * 5632) v = P.ffn_conv_b[i - SM_CONVB];
            B_SMALL[i] = v;
        }
        for (int i = blockIdx.x * 512 + tid; i < 2 * 768; i += G * 512) {
            const int dir = i / 768, c = i % 768; const float* p = P.hg_lb + (size_t)dir * 3 * 768 + c;
            const float a = p[0], b = p[768], cc = p[1536], mx = fmaxf(a, fmaxf(b, cc));
            const float ea = __expf(a - mx), eb = __expf(b - mx), ec = __expf(cc - mx);
            B_LB[i] = ea / (ea + eb + ec);
        }
    }

}

struct GArgs { unsigned char* ws; float* out; const float* resP; const float* resS; int layer, write_aux, sub, pad; };
template <int KIND>
DI void b_gemm(GArgs a, LAS unsigned char* lds) {
    unsigned char* ws = a.ws;
    const int G = gridDim.x;
    pg8::Gemm g; int nM = 192, nN = 4;
    EpiAll<KIND> E{ws, a.out, a.resP, a.resS, (LAS float*)(lds + HALO_OFF), a.layer, a.write_aux};
    g.M = T; g.N = 1024; g.K = 1024; g.rs = 256; g.r0 = 0;
    if (KIND == EK_KV) { g.A = B_MEMB; g.Bt = B_WKV; nM = 6; nN = 4; }
    else if (KIND == EK_HG) { g.A = B_XB; g.Bt = B_WHG; nN = 16; }
    else if (KIND == EK_GQ) { g.A = B_XB; g.Bt = B_WGQ; nN = 6; }
    else if (KIND == EK_UP) { g.A = B_XB; g.Bt = B_WUP + (size_t)a.layer * 5632 * 1024; nM = NUP_TILES; nN = 22; g.rs = 254; g.r0 = -1; }
    else if (a.sub == 0) { g.A = B_MIXA; g.Bt = B_WOUT + (size_t)a.layer * 1024 * 1024; }
    else { g.A = B_ACT; g.Bt = B_WDN + (size_t)a.layer * 1024 * DFF; g.K = DFF; }
    pg8::StaticOrder S; S.init(nM, nN, G, (int)blockIdx.x);
    pg8::gemm_phase<EpiAll<KIND>, pg8::StaticOrder, PG8_ALIGN, PG8_SP2>(lds, g, S, E);
}

template <bool OUT>
DI void b_gla(unsigned char* ws, float* out, LAS unsigned char* lds) {
    KPRE
    gla_wg<OUT>(B_QH, B_GT, B_VT, B_US, B_DEC, B_OF, B_OB, lds, wave, lane);
}
DI void b_scan(unsigned char* ws) {
    KPRE
    const int G2 = G - 24, gw2 = wave * G2 + ((int)blockIdx.x - 24);
    const int W_ = G2 * 8, n2 = 288 * 8 - W_;
    if (n2 <= W_ - 768 || n2 <= 0) {
        if (gw2 < 288 * 8) { const int it2 = gw2 < 768 ? gw2 + 1536 : gw2 - 768; gla_scan_item(B_US, B_DEC, it2 >> 3, it2 & 7, lane); }
        if (n2 > 0 && gw2 >= 768 && gw2 < 768 + n2) { const int it = W_ + gw2 - 768; const int it2 = it - 768; gla_scan_item(B_US, B_DEC, it2 >> 3, it2 & 7, lane); }
    } else {
        for (int it = gw2; it < 288 * 8; it += W_) { const int it2 = it < 768 ? it + 1536 : it - 768; gla_scan_item(B_US, B_DEC, it2 >> 3, it2 & 7, lane); }
    }
}
template <int LAYER>
DI void b_mix(unsigned char* ws, float* out, LAS unsigned char* lds) {
    KPRE
    if (LAYER == 0) {
        for (int r = gw; r < T; r += NGW) {
            const bf16_t* of = B_OF + (size_t)r * 768; const bf16_t* ob = B_OB + (size_t)r * 768; const bf16_t* go = r < 32768 ? B_GO1 + (size_t)r * 768 : B_GO2 + (size_t)(r - 32768) * 768;
            float o[12]; float ss = 0.f;
    #pragma unroll
            for (int j = 0; j < 3; ++j) {
                const u32x2 a = *(const u32x2*)(of + 256 * j + 4 * lane), b = *(const u32x2*)(ob + 256 * j + 4 * lane);
                o[4 * j] = __uint_as_float(a.x << 16) + __uint_as_float(b.x << 16); o[4 * j + 1] = __uint_as_float(a.x & 0xffff0000u) + __uint_as_float(b.x & 0xffff0000u);
                o[4 * j + 2] = __uint_as_float(a.y << 16) + __uint_as_float(b.y << 16); o[4 * j + 3] = __uint_as_float(a.y & 0xffff0000u) + __uint_as_float(b.y & 0xffff0000u);
    #pragma unroll
                for (int i = 0; i < 4; ++i) ss += o[4 * j + i] * o[4 * j + i];
            }
            ss = wave_sum(ss);
            const float rn = __builtin_amdgcn_rsqf(ss * (1.0f / 768.0f) + EPS);
    #pragma unroll
            for (int j = 0; j < 3; ++j) {
                const u32x2 gv = *(const u32x2*)(go + 256 * j + 4 * lane); const f32x4 gn = *(const f32x4*)(B_SMALL + SM_HGGN + 256 * j + 4 * lane);
                u32x2 w; w.x = pk2(o[4 * j] * rn * gn.x * siluf(__uint_as_float(gv.x << 16)), o[4 * j + 1] * rn * gn.y * siluf(__uint_as_float(gv.x & 0xffff0000u)));
                w.y = pk2(o[4 * j + 2] * rn * gn.z * siluf(__uint_as_float(gv.y << 16)), o[4 * j + 3] * rn * gn.w * siluf(__uint_as_float(gv.y & 0xffff0000u)));
                *(u32x2*)(B_MIXA + (size_t)r * D + 256 * j + 4 * lane) = w;
            }
        }


    } else {
        win_attn_wg(B_Q1, B_K1, B_VT1, B_SMALL, B_MIXA, lds, tid, wave, lane);
    }
    cross_attn_wg(B_XQ, B_MK + (size_t)LAYER * MROWS * 256, B_MVT + (size_t)LAYER * 6 * 256 * 256, B_MIXA, B_SMALL[SM_BND + LAYER], lds, tid, wave, lane);
}

#define OPQ() size_t zo_ = 0; asm volatile("" : "+s"(zo_)); unsigned char* ws = P.ws + zo_; float* out = (float*)((unsigned char*)P.out + zo_);
DI void gbar(unsigned char* wsb, unsigned k) {
    __syncthreads();
    if (threadIdx.x == 0) {
        unsigned* base = (unsigned*)(wsb + WS_END);
        const unsigned grp = blockIdx.x & 7u, ngrp = gridDim.x < 8u ? gridDim.x : 8u, gsz = (gridDim.x - grp + 7u) >> 3;
        __builtin_amdgcn_fence(__ATOMIC_RELEASE, "agent");
        const unsigned a = __hip_atomic_fetch_add(base + 64 * grp, 1u, __ATOMIC_RELAXED, __HIP_MEMORY_SCOPE_AGENT);
        if (a + 1u == k * gsz) {
            const unsigned b = __hip_atomic_fetch_add(base + 64 * 8, 1u, __ATOMIC_RELAXED, __HIP_MEMORY_SCOPE_AGENT);
            if (b + 1u == k * ngrp) __hip_atomic_store(base + 64 * 9, k, __ATOMIC_RELAXED, __HIP_MEMORY_SCOPE_AGENT);
        }
        while (__hip_atomic_load(base + 64 * 9, __ATOMIC_RELAXED, __HIP_MEMORY_SCOPE_AGENT) < k) __builtin_amdgcn_s_sleep(1);
        __builtin_amdgcn_fence(__ATOMIC_ACQUIRE, "agent");
    }
    __syncthreads();
}
__global__ void __launch_bounds__(512, 2) mega_fwd(Params P) {
    extern __shared__ __attribute__((aligned(16))) unsigned char lds_raw[];
    cg::grid_group grid = cg::this_grid();
    LAS unsigned char* lds = (LAS unsigned char*)lds_raw;
    if (blockIdx.x == 0 && threadIdx.x < 10) __hip_atomic_store((unsigned*)(P.ws + WS_END) + 64 * threadIdx.x, 0u, __ATOMIC_RELAXED, __HIP_MEMORY_SCOPE_AGENT);
    b_p0(P, lds);
    __syncthreads();
    grid.sync();
    { OPQ(); GArgs a{ws, out, out, out + (size_t)TP * D, 0, 1, 0, 0}; b_gemm<EK_HG>(a, lds); }
    gbar(P.ws, 1u);
    { OPQ(); b_gla<false>(ws, out, lds); }
    gbar(P.ws, 2u);
    if (blockIdx.x < 24) { OPQ(); GArgs a{ws, out, out, out + (size_t)TP * D, 0, 1, 0, 0}; b_gemm<EK_KV>(a, lds); }
    else { OPQ(); b_scan(ws); }
    gbar(P.ws, 3u);
    { OPQ(); b_gla<true>(ws, out, lds); }
    gbar(P.ws, 4u);
    { OPQ(); b_mix<0>(ws, out, lds); }
    gbar(P.ws, 5u);
    { OPQ(); GArgs a{ws, out, P.x_prompt, P.x_sample, 0, 1, 0, 0}; b_gemm<EK_RES>(a, lds); }
    gbar(P.ws, 6u);
    { OPQ(); GArgs a{ws, out, out, out + (size_t)TP * D, 0, 1, 1, 0}; b_gemm<EK_UP>(a, lds); }
    gbar(P.ws, 7u);
    { OPQ(); GArgs a{ws, out, out, out + (size_t)TP * D, 0, 1, 2, 0}; b_gemm<EK_RES>(a, lds); }
    gbar(P.ws, 8u);
    { OPQ(); GArgs a{ws, out, out, out + (size_t)TP * D, 1, 1, 0, 0}; b_gemm<EK_GQ>(a, lds); }
    gbar(P.ws, 9u);
    { OPQ(); b_mix<1>(ws, out, lds); }
    gbar(P.ws, 10u);
    { OPQ(); GArgs a{ws, out, out, out + (size_t)TP * D, 1, 1, 0, 0}; b_gemm<EK_RES>(a, lds); }
    gbar(P.ws, 11u);
    { OPQ(); GArgs a{ws, out, out, out + (size_t)TP * D, 1, 1, 1, 0}; b_gemm<EK_UP>(a, lds); }
    gbar(P.ws, 12u);
    { OPQ(); GArgs a{ws, out, out, out + (size_t)TP * D, 1, 0, 2, 0}; b_gemm<EK_RES>(a, lds); }
}

extern "C" void kernel_launch(void* const* d_in, const int* in_sizes, int n_in, void* d_out, int out_size, void* d_ws, size_t ws_size, hipStream_t stream) {
    static int grid = 0;
    if (grid == 0) {
        if (n_in != 22 || ws_size < WS_END + 4096) { fprintf(stderr, "kernel_launch: unexpected n_in %d or ws_size %zu (< %zu)\n", n_in, ws_size, (size_t)WS_END); grid = -1; return; }
        int dev = 0, cus = 0, per_cu = 0;
        (void)hipGetDevice(&dev); (void)hipDeviceGetAttribute(&cus, hipDeviceAttributeMultiprocessorCount, dev);
        if (hipFuncSetAttribute((const void*)mega_fwd, hipFuncAttributeMaxDynamicSharedMemorySize, LDS_BYTES) != hipSuccess) { fprintf(stderr, "kernel_launch: hipFuncSetAttribute failed\n"); grid = -1; return; }
        if (hipOccupancyMaxActiveBlocksPerMultiprocessor(&per_cu, (const void*)mega_fwd, 512, LDS_BYTES) != hipSuccess || per_cu < 1) { fprintf(stderr, "kernel_launch: occupancy query gave %d\n", per_cu); per_cu = 1; }
        (void)hipGetLastError();
        grid = (cus > 0 ? cus : 256) * 1;
    }
    if (grid < 0) return;
    Params p{};
    const float** pp = (const float**)&p;
    for (int i = 0; i < 22; ++i) pp[i] = (const float*)d_in[i];
    p.out = (float*)d_out; p.ws = (unsigned char*)d_ws;
    void* args[] = {&p};
    hipError_t e = hipLaunchCooperativeKernel((const void*)mega_fwd, dim3(grid), dim3(512), args, LDS_BYTES, stream);
    if (e != hipSuccess) fprintf(stderr, "cooperative launch failed: %s (grid %d)\n", hipGetErrorString(e), grid);
}
```

```cpp
#include <hip/hip_runtime.h>
#include <hip/hip_cooperative_groups.h>
#include <cstdio>
#include <cstdint>
namespace cg = cooperative_groups;

#define DI __device__ __forceinline__
#define LAS __attribute__((address_space(3)))
typedef unsigned short bf16_t;
typedef short bf16x8 __attribute__((ext_vector_type(8)));
typedef short s16x4 __attribute__((ext_vector_type(4)));
typedef float f32x4 __attribute__((ext_vector_type(4)));
typedef float f32x16 __attribute__((ext_vector_type(16)));
typedef unsigned u32x4 __attribute__((ext_vector_type(4)));
typedef unsigned u32x2 __attribute__((ext_vector_type(2)));
typedef __bf16 bf16v2 __attribute__((ext_vector_type(2)));

constexpr int T = 49152, TP = 16384, D = 1024, MIX = 768, XW = 256, DFF = 2816, MROWS = 1536;
constexpr float EPS = 1e-6f;
constexpr float LOG2E = 1.4426950408889634f;
constexpr float QSCALE = 0.125f * LOG2E;
constexpr int NUP_TILES = 194;

constexpr size_t MiB = 1u << 20;
constexpr size_t WS_WHG = 0, WS_WGQ = 8 * MiB, WS_WKV = 11 * MiB, WS_WOUT = 13 * MiB, WS_WUP = 17 * MiB, WS_WDN = 39 * MiB;
constexpr size_t WS_SSQ = 50 * MiB, WS_SSQM = 53 * MiB, WS_MEMB = 54 * MiB, WS_MK = 57 * MiB, WS_MVT = 59 * MiB;
constexpr size_t WS_ROPEC = 61 * MiB, WS_ROPES = 63 * MiB, WS_LB = 65 * MiB, WS_DEC = 66 * MiB;
constexpr size_t WS_XB = 69 * MiB;
constexpr size_t WS_US = WS_XB;
constexpr size_t WS_XQ = 166 * MiB;
constexpr size_t WS_R = 190 * MiB;
constexpr size_t WS_QH = WS_R, WS_VT = WS_R + 72 * MiB, WS_GT = WS_R + 144 * MiB, WS_MIXA = WS_R + 144 * MiB;
constexpr size_t WS_ACT = WS_R;
constexpr size_t WS_Q1 = WS_R, WS_K1 = WS_R + 72 * MiB, WS_VT1 = WS_R + 96 * MiB;
constexpr size_t WS_GO2 = 478 * MiB;
constexpr size_t WS_END = 502 * MiB;
constexpr size_t WS_SMALL = 67 * MiB + 512 * 1024;
constexpr int SM_XQN = 0, SM_XKN = 128, SM_GQQN = 256, SM_GQKN = 320, SM_SINK = 384, SM_HGGN = 512, SM_CONVW = 2048, SM_CONVB = 36864, SM_BND = 400  , SM_END = 48128;
#define B_WHG ((bf16_t*)(ws + WS_WHG))
#define B_WGQ ((bf16_t*)(ws + WS_WGQ))
#define B_WKV ((bf16_t*)(ws + WS_WKV))
#define B_WOUT ((bf16_t*)(ws + WS_WOUT))
#define B_WUP ((bf16_t*)(ws + WS_WUP))
#define B_WDN ((bf16_t*)(ws + WS_WDN))
#define B_SSQ ((float*)(ws + WS_SSQ))
#define B_SSQM ((float*)(ws + WS_SSQM))
#define B_MEMB ((bf16_t*)(ws + WS_MEMB))
#define B_MK ((bf16_t*)(ws + WS_MK))
#define B_MVT ((bf16_t*)(ws + WS_MVT))
#define B_ROPEC ((float*)(ws + WS_ROPEC))
#define B_ROPES ((float*)(ws + WS_ROPES))
#define B_LB ((float*)(ws + WS_LB))
#define B_DEC ((float*)(ws + WS_DEC))
#define B_XB ((bf16_t*)(ws + WS_XB))
#define B_US ((bf16_t*)(ws + WS_US))
#define B_XQ ((bf16_t*)(ws + WS_XQ))
#define B_QH ((bf16_t*)(ws + WS_QH))
#define B_VT ((bf16_t*)(ws + WS_VT))
#define B_GT ((bf16_t*)(ws + WS_GT))
#define B_MIXA ((bf16_t*)(ws + WS_MIXA))
#define B_ACT ((bf16_t*)(ws + WS_ACT))
#define B_Q1 ((bf16_t*)(ws + WS_Q1))
#define B_K1 ((bf16_t*)(ws + WS_K1))
#define B_VT1 ((bf16_t*)(ws + WS_VT1))
#define B_GO2 ((bf16_t*)(ws + WS_GO2))
#define B_SMALL ((float*)(ws + WS_SMALL))
#define B_OF ((bf16_t*)out)
#define B_OB ((bf16_t*)out + (size_t)T * 768)
#define B_GO1 ((bf16_t*)out + (size_t)2 * T * 768)

constexpr int LDS_BYTES = 147456;
constexpr int HALO_OFF = 131072;

DI float bf2f(short s) { return __uint_as_float(((unsigned)(unsigned short)s) << 16); }
DI unsigned pk2(float a, float b) { bf16v2 v; v.x = (__bf16)a; v.y = (__bf16)b; return __builtin_bit_cast(unsigned, v); }
DI bf16_t f2bf(float a) { __bf16 v = (__bf16)a; return __builtin_bit_cast(unsigned short, v); }
DI bf16x8 mk8(float a0, float a1, float a2, float a3, float a4, float a5, float a6, float a7) {
    u32x4 p; p.x = pk2(a0, a1); p.y = pk2(a2, a3); p.z = pk2(a4, a5); p.w = pk2(a6, a7); return __builtin_bit_cast(bf16x8, p); }
template <int S> DI bf16x8 pack8(const f32x16& x) { return mk8(x[8 * S], x[8 * S + 1], x[8 * S + 2], x[8 * S + 3], x[8 * S + 4], x[8 * S + 5], x[8 * S + 6], x[8 * S + 7]); }
DI bf16x8 ld_frag2(const bf16_t* p) { const s16x4 lo = *(const s16x4*)p; const s16x4 hi = *(const s16x4*)(p + 8); return __builtin_shufflevector(lo, hi, 0, 1, 2, 3, 4, 5, 6, 7); }
DI int crow(int reg, int h) { return (reg & 3) + 8 * (reg >> 2) + 4 * h; }
DI float ex2(float x) { return __builtin_amdgcn_exp2f(x); }
DI float rcpf(float x) { return __builtin_amdgcn_rcpf(x); }
DI float siluf(float x) { return x * rcpf(1.0f + ex2(-x * LOG2E)); }
DI float wave_sum(float v) {
#pragma unroll
    for (int o = 1; o < 64; o <<= 1) v += __shfl_xor(v, o);
    return v; }
DI int seq_start(int r) { return r < TP ? (r & ~4095) : TP + ((r - TP) & ~16383); }
DI int seq_end(int r) { return r < TP ? (r & ~4095) + 4096 : TP + ((r - TP) & ~16383) + 16384; }
DI int seq_of(int r) { return r < TP ? (r >> 12) : 4 + ((r - TP) >> 14); }
DI bool is_seq_start(int r) { return r < TP ? ((r & 4095) == 0) : (((r - TP) & 16383) == 0); }
#define MFMA32(a, b, c) __builtin_amdgcn_mfma_f32_32x32x16_bf16((a), (b), (c), 0, 0, 0)
#define LDS_WAIT() asm volatile("s_waitcnt lgkmcnt(0)" ::: "memory")

struct Params {
    const float *x_prompt, *x_sample, *mem_prompt, *mem_sample, *norm_mix, *norm_mem, *norm_ffn, *hg_w_in, *hg_lb, *hg_gn, *gq_w_in,
                *gq_qn, *gq_kn, *gq_sink, *x_w_kv, *x_qn, *x_kn, *w_out, *ffn_w_up, *ffn_conv_w, *ffn_conv_b, *ffn_w_down;
    float* out; unsigned char* ws;
};

namespace pg8 {
#define PG8_LAS __attribute__((address_space(3)))
typedef unsigned short bf16_t;
typedef short bf16x8 __attribute__((ext_vector_type(8)));
typedef float f32x4 __attribute__((ext_vector_type(4)));
typedef unsigned u32x4 __attribute__((ext_vector_type(4)));
constexpr int BM = 256, BK = 64, HALF = 128, HTB = HALF * BK * 2  , STAGE_BYTES = 8 * HTB, NXCD = 8, WGM = 8;

__host__ __device__ __forceinline__ int lds_byte(int r, int c) { const int st = (r >> 4) * 2 + (c >> 5), rr = r & 15, cc = c & 31, ob = rr * 64 + cc * 2; return st * 1024 + (ob ^ (((ob >> 9) & 1) << 5)); }
__host__ __device__ __forceinline__ void stage_rc(int b, int& R, int& C) { const int st = b / 1024, sb = b % 1024, swz = sb ^ (((sb >> 9) & 1) << 5); R = (st >> 1) * 16 + swz / 64; C = (st & 1) * 32 + (swz % 64) / 2; }
__host__ __device__ __forceinline__ int perm32(int rho) { const int n = rho >> 4, i = rho & 15; return 8 * (i >> 2) + 4 * n + (i & 3); }

struct Unit { int pm, pn; };
struct Gemm { const bf16_t* A; const bf16_t* Bt; int M, N, K; int rs, r0; };

struct StaticOrder {
    int nM, nN, nwg, G, c, rev;
    __host__ __device__ void init(int nM_, int nN_, int G_, int c_) { nM = nM_; nN = nN_; nwg = nM * nN; G = G_; c = c_; rev = 0; }
    __host__ __device__ bool next(int i, Unit& u) const {
        const long L = (long)i * G + c; if (L >= nwg) return false;
        int wgid = (int)L; { const int q = nwg / NXCD, r = nwg % NXCD, xcd = wgid % NXCD, off = wgid / NXCD; wgid = (xcd < r ? xcd * (q + 1) : r * (q + 1) + (xcd - r) * q) + off; }
        const int nig = WGM * nN, gid = wgid / nig, fm = gid * WGM, gsz = (nM - fm) < WGM ? (nM - fm) : WGM;
        u.pm = fm + ((wgid % nig) % gsz); u.pn = (wgid % nig) / gsz; if (rev) u.pm = nM - 1 - u.pm; return true;
    }
    __device__ __forceinline__ void a_ready(const Unit&) const {}
    __device__ __forceinline__ void done(const Unit&) const {}
};

__device__ __forceinline__ unsigned cvt_pk_bf16(float lo, float hi) { unsigned r; asm volatile("v_cvt_pk_bf16_f32 %0, %1, %2" : "=v"(r) : "v"(lo), "v"(hi)); return r; }
template <class Epi, class Sched, bool ALIGN_EPI = false, bool SP2 = false>
__device__ __forceinline__ void gemm_phase(PG8_LAS unsigned char* lds, const Gemm g, const Sched& S, const Epi& E) {
    int tid_o = threadIdx.x; asm volatile("" : "+v"(tid_o)); const int tid = tid_o, wid = __builtin_amdgcn_readfirstlane(tid >> 6), lane = tid & 63, wr = wid >> 2, wc = wid & 3, fr = lane & 15, fq = lane >> 4;
    const int K = g.K, nt = K / BK;
    unsigned voffA[2], voffB[2];
#pragma unroll
    for (int i = 0; i < 2; ++i) { int R, C; stage_rc(tid * 16 + i * 8192, R, C); const int Rb = Epi::PERM ? ((R & ~31) + perm32(R & 31)) : R;
        const int Ra = (R & 64) + 4 * (R & 15) + ((R >> 4) & 3); voffA[i] = (unsigned)(Ra * K + C) * 2u;     voffB[i] = (unsigned)(Rb * K + C) * 2u; }
    const size_t kstep = (size_t)(BK * 2);
    const size_t hstep = (size_t)HALF * K * 2;
    const size_t tstep = 2 * hstep;
    const unsigned ldsw = (unsigned)wid * 1024u;
    const int aoff = lds_byte(wr * 64 + fr, fq * 8), boff = lds_byte(wc * 32 + fr, fq * 8);
#define PG8_SA(b, h) (((b) * 2 + (h)) * HTB)
#define PG8_SB(b, h) ((4 + (b) * 2 + (h)) * HTB)
#define PG8_STAGE(bufoff, gbase, voff) do { _Pragma("unroll") for (int _i = 0; _i < 2; ++_i) \
        __builtin_amdgcn_global_load_lds((const unsigned*)((const char*)(gbase) + (voff)[_i]), (PG8_LAS unsigned*)(lds + (bufoff) + ldsw + _i * 8192), 16, 0, 0); } while (0)
#define PG8_LDA(dst, b, h) do { _Pragma("unroll") for (int m = 0; m < 4; ++m) _Pragma("unroll") for (int k = 0; k < 2; ++k) dst[m][k] = *(const PG8_LAS bf16x8*)(lds + PG8_SA(b, h) + aoff + m * 2048 + k * 1024); } while (0)
#define PG8_LDB(dst, b, h) do { _Pragma("unroll") for (int n = 0; n < 2; ++n) _Pragma("unroll") for (int k = 0; k < 2; ++k) dst[n][k] = *(const PG8_LAS bf16x8*)(lds + PG8_SB(b, h) + boff + n * 2048 + k * 1024); } while (0)
#define PG8_MMA(ai, bj, At, Bt) do { __builtin_amdgcn_s_setprio(1); _Pragma("unroll") for (int m = 0; m < 4; ++m) _Pragma("unroll") for (int n = 0; n < 2; ++n) _Pragma("unroll") for (int k = 0; k < 2; ++k) \
        acc[ai][bj][m][n] = __builtin_amdgcn_mfma_f32_16x16x32_bf16(Bt[n][k], At[m][k], acc[ai][bj][m][n], 0, 0, 0); __builtin_amdgcn_s_setprio(0); } while (0)
#define PG8_WAIT_V(n) asm volatile("s_waitcnt vmcnt(" #n ")" ::: "memory")
#define PG8_WAIT_L(n) asm volatile("s_waitcnt lgkmcnt(" #n ")" ::: "memory")
#define PG8_BAR __builtin_amdgcn_s_barrier()
#define PG8_SCHED __builtin_amdgcn_sched_barrier(0)
    Unit cur, nxt; int ui = 0;
    if (!S.next(0, cur)) return;
    f32x4 acc[2][2][4][2];
#pragma unroll
    for (int a = 0; a < 2; ++a)
#pragma unroll
        for (int b = 0; b < 2; ++b)
#pragma unroll
            for (int m = 0; m < 4; ++m)
#pragma unroll
                for (int n = 0; n < 2; ++n) acc[a][b][m][n] = (f32x4){0.f, 0.f, 0.f, 0.f};
    bf16x8 At[4][2], B0[2][2], B1[2][2];
    const char* cA = (const char*)g.A + ((long)cur.pm * g.rs + g.r0) * (long)(K * 2); const char* cB = (const char*)g.Bt + (size_t)cur.pn * tstep;
    S.a_ready(cur);
    if constexpr (SP2) {
        PG8_STAGE(PG8_SB(0, 0), cB, voffB); PG8_STAGE(PG8_SB(0, 1), cB + hstep, voffB); PG8_STAGE(PG8_SA(0, 0), cA, voffA); PG8_STAGE(PG8_SA(0, 1), cA + hstep, voffA);
        if (wr == 1) PG8_BAR;
        PG8_WAIT_V(2); PG8_BAR;
        PG8_STAGE(PG8_SB(1, 0), cB + kstep, voffB); PG8_STAGE(PG8_SA(1, 0), cA + kstep, voffA); PG8_STAGE(PG8_SB(1, 1), cB + hstep + kstep, voffB);
        PG8_WAIT_V(6); PG8_BAR;
    } else {
        PG8_STAGE(PG8_SB(0, 0), cB, voffB); PG8_STAGE(PG8_SA(0, 0), cA, voffA); PG8_STAGE(PG8_SB(0, 1), cB + hstep, voffB); PG8_STAGE(PG8_SA(0, 1), cA + hstep, voffA);
        if (wr == 1) PG8_BAR;
        PG8_WAIT_V(4); PG8_BAR;
        PG8_STAGE(PG8_SB(1, 0), cB + kstep, voffB); PG8_STAGE(PG8_SA(1, 0), cA + kstep, voffA); PG8_STAGE(PG8_SB(1, 1), cB + hstep + kstep, voffB);
        PG8_WAIT_V(6); PG8_BAR;
    }
    for (;;) {
        const bool has_next = S.next(ui + 1, nxt);
        const char* nA = has_next ? (const char*)g.A + ((long)nxt.pm * g.rs + g.r0) * (long)(K * 2) : cA; const char* nB = has_next ? (const char*)g.Bt + (size_t)nxt.pn * tstep : cB;
        for (int t = 0; t < nt; t += 2) {
            const bool last = (t == nt - 2);
            const char* a1 = cA + (size_t)(t + 1) * kstep;
            const char* a2 = last ? nA : cA + (size_t)(t + 2) * kstep; const char* b2 = last ? nB : cB + (size_t)(t + 2) * kstep;
            const char* a3 = a2 + kstep; const char* b3 = b2 + kstep;
            if (last && has_next) S.a_ready(nxt);
            if constexpr (SP2) {
            PG8_LDB(B0, 0, 0); PG8_LDB(B1, 0, 1); PG8_SCHED; PG8_LDA(At, 0, 0); PG8_STAGE(PG8_SA(1, 1), a1 + hstep, voffA);
            PG8_WAIT_V(8); PG8_WAIT_L(0); PG8_BAR; PG8_MMA(0, 0, At, B0); PG8_MMA(0, 1, At, B1); PG8_BAR; PG8_SCHED;
            PG8_LDA(At, 0, 1); PG8_STAGE(PG8_SB(0, 0), b2, voffB); PG8_STAGE(PG8_SB(0, 1), b2 + hstep, voffB); PG8_STAGE(PG8_SA(0, 0), a2, voffA);
            PG8_WAIT_V(8); PG8_WAIT_L(0); PG8_BAR; PG8_MMA(1, 0, At, B0); PG8_MMA(1, 1, At, B1); PG8_BAR; PG8_SCHED;
            PG8_LDB(B0, 1, 0); PG8_LDB(B1, 1, 1); PG8_SCHED; PG8_LDA(At, 1, 0); PG8_STAGE(PG8_SA(0, 1), a2 + hstep, voffA);
            PG8_WAIT_V(8); PG8_WAIT_L(0); PG8_BAR; PG8_MMA(0, 0, At, B0); PG8_MMA(0, 1, At, B1); PG8_BAR; PG8_SCHED;
            PG8_LDA(At, 1, 1); PG8_STAGE(PG8_SB(1, 0), b3, voffB); PG8_STAGE(PG8_SB(1, 1), b3 + hstep, voffB); PG8_STAGE(PG8_SA(1, 0), a3, voffA);
            PG8_WAIT_V(8); PG8_WAIT_L(0); PG8_BAR; PG8_MMA(1, 0, At, B0); PG8_MMA(1, 1, At, B1); PG8_BAR; PG8_SCHED;
            } else {
            PG8_LDB(B0, 0, 0); PG8_SCHED; PG8_LDA(At, 0, 0); PG8_STAGE(PG8_SA(1, 1), a1 + hstep, voffA);
            PG8_WAIT_L(8); PG8_BAR; PG8_WAIT_L(0); PG8_MMA(0, 0, At, B0); PG8_BAR; PG8_SCHED;
            PG8_LDB(B1, 0, 1); PG8_STAGE(PG8_SB(0, 0), b2, voffB);
            PG8_BAR; PG8_WAIT_L(0); PG8_MMA(0, 1, At, B1); PG8_BAR;
            PG8_LDA(At, 0, 1); PG8_STAGE(PG8_SA(0, 0), a2, voffA);
            PG8_BAR; PG8_WAIT_L(0); PG8_MMA(1, 0, At, B0); PG8_BAR; PG8_SCHED;
            PG8_STAGE(PG8_SB(0, 1), b2 + hstep, voffB);
            PG8_WAIT_V(6); PG8_BAR; PG8_MMA(1, 1, At, B1); PG8_BAR;
            PG8_LDB(B0, 1, 0); PG8_SCHED; PG8_LDA(At, 1, 0); PG8_STAGE(PG8_SA(0, 1), a2 + hstep, voffA);
            PG8_WAIT_L(8); PG8_BAR; PG8_WAIT_L(0); PG8_MMA(0, 0, At, B0); PG8_BAR; PG8_SCHED;
            PG8_LDB(B1, 1, 1); PG8_STAGE(PG8_SB(1, 0), b3, voffB);
            PG8_BAR; PG8_WAIT_L(0); PG8_MMA(0, 1, At, B1); PG8_BAR;
            PG8_LDA(At, 1, 1); PG8_STAGE(PG8_SA(1, 0), a3, voffA);
            PG8_BAR; PG8_WAIT_L(0); PG8_MMA(1, 0, At, B0); PG8_BAR; PG8_SCHED;
            PG8_STAGE(PG8_SB(1, 1), b3 + hstep, voffB);
            PG8_WAIT_V(6); PG8_BAR; PG8_MMA(1, 1, At, B1); PG8_BAR;
            }
        }
        if constexpr (ALIGN_EPI) { if (wr == 0) PG8_BAR; }
        if constexpr (!Epi::AFTER_DRAIN) { E(acc, cur, wr, wc, fr, fq); S.done(cur); }
        if (!has_next) break;
#pragma unroll
        for (int a = 0; a < 2; ++a)
#pragma unroll
            for (int b = 0; b < 2; ++b)
#pragma unroll
                for (int m = 0; m < 4; ++m)
#pragma unroll
                    for (int n = 0; n < 2; ++n) acc[a][b][m][n] = (f32x4){0.f, 0.f, 0.f, 0.f};
        cur = nxt; cA = nA; cB = nB; ++ui;
        if constexpr (ALIGN_EPI) { if (wr == 1) PG8_BAR; }
    }
    PG8_WAIT_V(0);
    if constexpr (!ALIGN_EPI) { if (wr == 0) PG8_BAR; }
    PG8_BAR;
    if constexpr (Epi::AFTER_DRAIN) { E.fused(acc, cur, wr, wc, fr, fq, lds, wid, lane); S.done(cur); }
#undef PG8_SA
#undef PG8_SB
#undef PG8_STAGE
#undef PG8_LDA
#undef PG8_LDB
#undef PG8_MMA
#undef PG8_WAIT_V
#undef PG8_WAIT_L
#undef PG8_BAR
#undef PG8_SCHED
}
}

#define PG8_SP2 true
#define PG8_ALIGN true

DI float rstd16(const float* p) {
    const f32x4 a = ((const f32x4*)p)[0], b = ((const f32x4*)p)[1], c = ((const f32x4*)p)[2], d = ((const f32x4*)p)[3];
    const float s = ((a.x + a.y) + (a.z + a.w)) + ((b.x + b.y) + (b.z + b.w)) + ((c.x + c.y) + (c.z + c.w)) + ((d.x + d.y) + (d.z + d.w));
    return __builtin_amdgcn_rsqf(s * (1.0f / 1024.0f) + EPS);
}
DI float rstd4(const float* p) { const f32x4 a = *(const f32x4*)p; return __builtin_amdgcn_rsqf(((a.x + a.y) + (a.z + a.w)) * (1.0f / 1024.0f) + EPS); }
DI float sumsq4(const f32x4 a) { return (a.x * a.x + a.y * a.y) + (a.z * a.z + a.w * a.w); }

template <int CTRL> DI float dppf(float x) { return __builtin_bit_cast(float, __builtin_amdgcn_update_dpp(0, __builtin_bit_cast(int, x), CTRL, 0xf, 0xf, false)); }

enum { EK_KV = 0, EK_HG = 1, EK_GQ = 2, EK_RES = 3, EK_UP = 4 };
template <int KIND> struct EpiAll {
    static constexpr bool PERM = true, AFTER_DRAIN = false;
    unsigned char* ws; float* out; const float *resP, *resS; LAS float* halo; int layer, write_aux;
    DI void operator()(f32x4 (&acc)[2][2][4][2], const pg8::Unit& u, int wr, int wc, int fr, int fq) const {
        if (KIND == EK_HG) run_EpiHg(acc, u, wr, wc, fr, fq);
        else if (KIND == EK_GQ) run_EpiGq(acc, u, wr, wc, fr, fq);
        else if (KIND == EK_RES) run_EpiRes(acc, u, wr, wc, fr, fq);
        else if (KIND == EK_UP) run_EpiUp(acc, u, wr, wc, fr, fq);
        else run_EpiKv(acc, u, wr, wc, fr, fq);
    }
    DI void run_EpiHg(f32x4 (&acc)[2][2][4][2], const pg8::Unit& u, int wr_, int wc_, int fr_, int fq_) const {
        int t_ = threadIdx.x; asm volatile("" : "+v"(t_)); const int wr = t_ >> 8, wc = (t_ >> 6) & 3, fr = t_ & 15, fq = (t_ >> 4) & 3;
        const int kind = u.pn / 3, sub = u.pn - 3 * kind;
        const int cb = sub * 256 + wc * 32 + 8 * fq;
        float lbq[16];
        if (kind == 1 || kind == 2) {
#pragma unroll
            for (int q = 0; q < 16; ++q) lbq[q] = B_LB[(kind - 1) * 768 + cb + (q >> 3) * 128 + (q & 7)];
        }
        float rsa[2][4];
#pragma unroll
        for (int ai = 0; ai < 2; ++ai)
#pragma unroll
        for (int m = 0; m < 4; ++m) rsa[ai][m] = rstd4(B_SSQ + (size_t)(u.pm * 256 + ai * 128 + wr * 64 + 4 * fr + m) * 4);
#pragma unroll
        for (int ai = 0; ai < 2; ++ai) {
            const int r0 = u.pm * 256 + ai * 128 + wr * 64 + 4 * fr;
            float rs[4];
#pragma unroll
            for (int m = 0; m < 4; ++m) rs[m] = rsa[ai][m];
            if (kind == 0 || kind == 4) {
#pragma unroll
                for (int m = 0; m < 4; ++m) {
                    const int r = r0 + m;
                    bf16_t* dst = kind == 0 ? B_QH + (size_t)r * 768 : (r < 32768 ? B_GO1 + (size_t)r * 768 : B_GO2 + (size_t)(r - 32768) * 768);
#pragma unroll
                    for (int bj = 0; bj < 2; ++bj) {
                        const f32x4 a = acc[ai][bj][m][0] * rs[m], b = acc[ai][bj][m][1] * rs[m];
                        u32x4 w;
                        if (kind == 0) { w.x = pk2(siluf(a.x), siluf(a.y)); w.y = pk2(siluf(a.z), siluf(a.w)); w.z = pk2(siluf(b.x), siluf(b.y)); w.w = pk2(siluf(b.z), siluf(b.w)); }
                        else { w.x = pk2(a.x, a.y); w.y = pk2(a.z, a.w); w.z = pk2(b.x, b.y); w.w = pk2(b.z, b.w); }
                        *(u32x4*)(dst + cb + bj * 128) = w;
                    }
                }
            } else if (kind == 1 || kind == 2) {
                const float* lbp = B_LB + (kind - 1) * 768;
                bf16_t* gt = B_GT + (size_t)(kind - 1) * 768 * T + r0;
#pragma unroll
                for (int bj = 0; bj < 2; ++bj)
#pragma unroll
                for (int n = 0; n < 2; ++n)
#pragma unroll
                for (int j = 0; j < 4; ++j) {
                    const int c = cb + bj * 128 + 4 * n + j;
                    const float lbv = lbq[8 * bj + 4 * n + j]; float gv[4];
#pragma unroll
                    for (int m = 0; m < 4; ++m) { const float x = acc[ai][bj][m][n][j] * rs[m]; const float sg = rcpf(1.0f + ex2(-x * LOG2E)); gv[m] = __log2f(lbv + (1.0f - lbv) * sg); }
                    u32x2 w; w.x = pk2(gv[0], gv[1]); w.y = pk2(gv[2], gv[3]);
                    *(u32x2*)(gt + (size_t)c * T) = w;
                }
            } else if (kind == 3) {
                bf16_t* vt = B_VT + r0;
#pragma unroll
                for (int bj = 0; bj < 2; ++bj)
#pragma unroll
                for (int n = 0; n < 2; ++n)
#pragma unroll
                for (int j = 0; j < 4; ++j) {
                    const int c = cb + bj * 128 + 4 * n + j;
                    u32x2 w; w.x = pk2(acc[ai][bj][0][n][j] * rs[0], acc[ai][bj][1][n][j] * rs[1]); w.y = pk2(acc[ai][bj][2][n][j] * rs[2], acc[ai][bj][3][n][j] * rs[3]);
                    *(u32x2*)(vt + (size_t)c * T) = w;
                }
            } else {
#pragma unroll
                for (int m = 0; m < 4; ++m) {
                    const int r = r0 + m;
                    float ss = 0.f;
#pragma unroll
                    for (int bj = 0; bj < 2; ++bj)
#pragma unroll
                    for (int n = 0; n < 2; ++n) ss += sumsq4(acc[ai][bj][m][n]);
                    ss += __shfl_xor(ss, 16); ss += __shfl_xor(ss, 32);
                    const float rn = rs[m] * __builtin_amdgcn_rsqf(ss * rs[m] * rs[m] * (1.0f / 64.0f) + EPS) * QSCALE;
#pragma unroll
                    for (int bj = 0; bj < 2; ++bj) {
                        const f32x4 w0 = *(const f32x4*)(B_SMALL + SM_XQN + 32 * bj + 8 * fq), w1 = *(const f32x4*)(B_SMALL + SM_XQN + 32 * bj + 8 * fq + 4);
                        const f32x4 a = acc[ai][bj][m][0] * w0 * rn, b = acc[ai][bj][m][1] * w1 * rn;
                        u32x4 w; w.x = pk2(a.x, a.y); w.y = pk2(a.z, a.w); w.z = pk2(b.x, b.y); w.w = pk2(b.z, b.w);
                        *(u32x4*)(B_XQ + (size_t)r * 256 + 64 * wc + 32 * bj + 8 * fq) = w;
                    }
                }
            }
            asm volatile("" ::: "memory");
        }
    }
    DI void run_EpiGq(f32x4 (&acc)[2][2][4][2], const pg8::Unit& u, int wr_, int wc_, int fr_, int fq_) const {
        int t_ = threadIdx.x; asm volatile("" : "+v"(t_)); const int wr = t_ >> 8, wc = (t_ >> 6) & 3, fr = t_ & 15, fq = (t_ >> 4) & 3;
        const int pn = u.pn;
        float rsa[2][4];
#pragma unroll
        for (int ai = 0; ai < 2; ++ai)
#pragma unroll
        for (int m = 0; m < 4; ++m) rsa[ai][m] = rstd4(B_SSQ + (size_t)(u.pm * 256 + ai * 128 + wr * 64 + 4 * fr + m) * 4);
#pragma unroll
        for (int ai = 0; ai < 2; ++ai) {
            const int r0 = u.pm * 256 + ai * 128 + wr * 64 + 4 * fr;
            float rs[4];
#pragma unroll
            for (int m = 0; m < 4; ++m) rs[m] = rsa[ai][m];
            if (pn == 4) {
                bf16_t* vt = B_VT1 + r0;
#pragma unroll
                for (int bj = 0; bj < 2; ++bj)
#pragma unroll
                for (int n = 0; n < 2; ++n)
#pragma unroll
                for (int j = 0; j < 4; ++j) {
                    const int c = 64 * wc + 32 * bj + 8 * fq + 4 * n + j;
                    u32x2 w; w.x = pk2(acc[ai][bj][0][n][j] * rs[0], acc[ai][bj][1][n][j] * rs[1]); w.y = pk2(acc[ai][bj][2][n][j] * rs[2], acc[ai][bj][3][n][j] * rs[3]);
                    *(u32x2*)(vt + (size_t)c * T) = w;
                }
            } else {
#pragma unroll
                for (int m = 0; m < 4; ++m) {
                    const int r = r0 + m;
                    float ss = 0.f;
#pragma unroll
                    for (int bj = 0; bj < 2; ++bj)
#pragma unroll
                    for (int n = 0; n < 2; ++n) ss += sumsq4(acc[ai][bj][m][n]);
                    ss += __shfl_xor(ss, 16); ss += __shfl_xor(ss, 32);
                    const float rn = rs[m] * __builtin_amdgcn_rsqf(ss * rs[m] * rs[m] * (1.0f / 64.0f) + EPS);
                    const float* wv = B_SMALL + (pn < 3 ? SM_GQQN : (pn == 3 ? SM_GQKN : SM_XQN + 64));
                    const float sc = (pn == 3) ? 1.0f : QSCALE;
                    bf16_t* dst = pn < 3 ? B_Q1 + (size_t)r * 768 + 64 * (4 * pn + wc) : (pn == 3 ? B_K1 + (size_t)r * 256 + 64 * wc : B_XQ + (size_t)r * 256 + 64 * wc);
                    const int pos = r - seq_start(r);
                    u32x2 k1, k2;
#pragma unroll
                    for (int n = 0; n < 2; ++n) {
                        f32x4 x1 = acc[ai][0][m][n] * rn * *(const f32x4*)(wv + 8 * fq + 4 * n), x2 = acc[ai][1][m][n] * rn * *(const f32x4*)(wv + 32 + 8 * fq + 4 * n);
                        if (pn <= 3) {
                            const f32x4 cs = *(const f32x4*)(B_ROPEC + (size_t)pos * 32 + 8 * fq + 4 * n), sn = *(const f32x4*)(B_ROPES + (size_t)pos * 32 + 8 * fq + 4 * n);
                            const f32x4 t1 = x1 * cs - x2 * sn, t2 = x2 * cs + x1 * sn; x1 = t1; x2 = t2;
                        }
                        x1 = x1 * sc; x2 = x2 * sc;
                        if (n == 0) { k1.x = pk2(x1.x, x1.y); k1.y = pk2(x1.z, x1.w); k2.x = pk2(x2.x, x2.y); k2.y = pk2(x2.z, x2.w); }
                        else {
                            u32x4 w; w.x = k1.x; w.y = k1.y; w.z = pk2(x1.x, x1.y); w.w = pk2(x1.z, x1.w); *(u32x4*)(dst + 8 * fq) = w;
                            w.x = k2.x; w.y = k2.y; w.z = pk2(x2.x, x2.y); w.w = pk2(x2.z, x2.w); *(u32x4*)(dst + 32 + 8 * fq) = w;
                        }
                    }
                    asm volatile("" ::: "memory");
                }
            }
        }
    }
    DI void run_EpiKv(f32x4 (&acc)[2][2][4][2], const pg8::Unit& u, int wr_, int wc_, int fr_, int fq_) const {
        int t_ = threadIdx.x; asm volatile("" : "+v"(t_)); const int wr = t_ >> 8, wc = (t_ >> 6) & 3, fr = t_ & 15, fq = (t_ >> 4) & 3;
        const int layer = u.pn >> 1, isv = u.pn & 1;
#pragma unroll
        for (int ai = 0; ai < 2; ++ai) {
            const int r0 = u.pm * 256 + ai * 128 + wr * 64 + 4 * fr;
            float rs[4];
#pragma unroll
            for (int m = 0; m < 4; ++m) { const f32x4 q4 = *(const f32x4*)(B_SSQM + (size_t)(r0 + m) * 4); rs[m] = __builtin_amdgcn_rsqf(((q4.x + q4.y) + (q4.z + q4.w)) * (1.0f / 1024.0f) + EPS); }
            if (isv) {
                bf16_t* vt = B_MVT + ((size_t)(layer * 6 + (r0 >> 8)) * 256) * 256 + (r0 & 255);
#pragma unroll
                for (int bj = 0; bj < 2; ++bj)
#pragma unroll
                for (int n = 0; n < 2; ++n)
#pragma unroll
                for (int j = 0; j < 4; ++j) {
                    const int c = 64 * wc + 32 * bj + 8 * fq + 4 * n + j;
                    u32x2 w; w.x = pk2(acc[ai][bj][0][n][j] * rs[0], acc[ai][bj][1][n][j] * rs[1]); w.y = pk2(acc[ai][bj][2][n][j] * rs[2], acc[ai][bj][3][n][j] * rs[3]);
                    *(u32x2*)(vt + (size_t)c * 256) = w;
                }
            } else {
#pragma unroll
                for (int m = 0; m < 4; ++m) {
                    const int r = r0 + m;
                    float ss = 0.f;
#pragma unroll
                    for (int bj = 0; bj < 2; ++bj)
#pragma unroll
                    for (int n = 0; n < 2; ++n) ss += sumsq4(acc[ai][bj][m][n]);
                    ss += __shfl_xor(ss, 16); ss += __shfl_xor(ss, 32);
                    const float rn = rs[m] * __builtin_amdgcn_rsqf(ss * rs[m] * rs[m] * (1.0f / 64.0f) + EPS);
                    const float* wv = B_SMALL + SM_XKN + 64 * layer;
#pragma unroll
                    for (int bj = 0; bj < 2; ++bj) {
                        const f32x4 a = acc[ai][bj][m][0] * rn * *(const f32x4*)(wv + 32 * bj + 8 * fq), b = acc[ai][bj][m][1] * rn * *(const f32x4*)(wv + 32 * bj + 8 * fq + 4);
                        u32x4 w; w.x = pk2(a.x, a.y); w.y = pk2(a.z, a.w); w.z = pk2(b.x, b.y); w.w = pk2(b.z, b.w);
                        *(u32x4*)(B_MK + ((size_t)layer * MROWS + r) * 256 + 64 * wc + 32 * bj + 8 * fq) = w;
                    }
                }
            }
        }
    }
    DI void run_EpiRes(f32x4 (&acc)[2][2][4][2], const pg8::Unit& u, int wr_, int wc_, int fr_, int fq_) const {
        int t_ = threadIdx.x; asm volatile("" : "+v"(t_)); const int wr = t_ >> 8, wc = (t_ >> 6) & 3, fr = t_ & 15, fq = (t_ >> 4) & 3;
#pragma unroll
        for (int ai = 0; ai < 2; ++ai)
#pragma unroll
        for (int mp = 0; mp < 2; ++mp) {
            f32x4 rv[2][2][2];
#pragma unroll
            for (int mm = 0; mm < 2; ++mm) {
                const int r = u.pm * 256 + ai * 128 + wr * 64 + 4 * fr + 2 * mp + mm;
                const float* res = r < TP ? resP + (size_t)r * D : resS + (size_t)(r - TP) * D;
#pragma unroll
                for (int bj = 0; bj < 2; ++bj)
#pragma unroll
                for (int n = 0; n < 2; ++n) rv[mm][bj][n] = *(const f32x4*)(res + u.pn * 256 + bj * 128 + wc * 32 + 8 * fq + 4 * n);
            }
#pragma unroll
            for (int mm = 0; mm < 2; ++mm) {
                const int m = 2 * mp + mm;
                const int r = u.pm * 256 + ai * 128 + wr * 64 + 4 * fr + m;
                float ss = 0.f;
#pragma unroll
                for (int bj = 0; bj < 2; ++bj) {
                    const int c = u.pn * 256 + bj * 128 + wc * 32 + 8 * fq;
                    const f32x4 x0 = rv[mm][bj][0] + acc[ai][bj][m][0], x1 = rv[mm][bj][1] + acc[ai][bj][m][1];
                    *(f32x4*)(out + (size_t)r * D + c) = x0; *(f32x4*)(out + (size_t)r * D + c + 4) = x1;
                    ss += sumsq4(x0) + sumsq4(x1);
                    if (write_aux) { u32x4 w; w.x = pk2(x0.x, x0.y); w.y = pk2(x0.z, x0.w); w.z = pk2(x1.x, x1.y); w.w = pk2(x1.z, x1.w); *(u32x4*)(B_XB + (size_t)r * D + c) = w; }
                }
                ss += __shfl_xor(ss, 16); ss += __shfl_xor(ss, 32);
                if (write_aux && fq == 0) halo[(ai * 128 + wr * 64 + 4 * fr + m) * 4 + wc] = ss;
            }
            asm volatile("" ::: "memory");
        }
        if (write_aux) {
            asm volatile("s_waitcnt lgkmcnt(0)" ::: "memory"); __builtin_amdgcn_s_barrier(); asm volatile("" ::: "memory");
            if (t_ < 256) { const f32x4 q = *(const LAS f32x4*)(halo + t_ * 4); B_SSQ[(size_t)(u.pm * 256 + t_) * 4 + u.pn] = (q.x + q.y) + (q.z + q.w); }
            asm volatile("s_waitcnt lgkmcnt(0)" ::: "memory"); __builtin_amdgcn_s_barrier(); asm volatile("" ::: "memory");
        }
    }
    DI void run_EpiUp(f32x4 (&acc)[2][2][4][2], const pg8::Unit& u, int wr_, int wc_, int fr_, int fq_) const {
        int t_ = threadIdx.x; asm volatile("" : "+v"(t_)); const int wr = t_ >> 8, wc = (t_ >> 6) & 3, fr = t_ & 15, fq = (t_ >> 4) & 3;
        const int slot = wc * 32 + 8 * fq;
        const int g0r = u.pm * 254 - 1;
        const bool hasb = (g0r < 0) || ((g0r + 255) >= T) || (g0r < TP ? (((g0r + 256) & ~4095) > g0r) : ((((g0r - TP) + 256) & ~16383) > (g0r - TP)));
#pragma unroll
        for (int ai = 0; ai < 2; ++ai)
#pragma unroll
        for (int m = 0; m < 4; ++m) {
            const int gr = g0r + ai * 128 + wr * 64 + 4 * fr + m;
            const bool ok = gr >= 0 && gr < T;
            const float rs = ok ? rstd4(B_SSQ + (size_t)(ok ? gr : 0) * 4) : 0.f;
#pragma unroll
            for (int bj = 0; bj < 2; ++bj)
#pragma unroll
            for (int n = 0; n < 2; ++n) acc[ai][bj][m][n] = acc[ai][bj][m][n] * rs;
        }
#pragma unroll
        for (int ai = 0; ai < 2; ++ai) {
            const int b = 2 * ai + wr;
#pragma unroll
            for (int bj = 0; bj < 2; ++bj)
#pragma unroll
            for (int n = 0; n < 2; ++n) {
                if (fr == 0) *(LAS f32x4*)(halo + (0 * 4 + b) * 256 + bj * 128 + slot + 4 * n) = acc[ai][bj][0][n];
                if (fr == 15) *(LAS f32x4*)(halo + (1 * 4 + b) * 256 + bj * 128 + slot + 4 * n) = acc[ai][bj][3][n];
            }
        }
        asm volatile("s_waitcnt lgkmcnt(0)" ::: "memory"); __builtin_amdgcn_s_barrier(); asm volatile("" ::: "memory");
        const float* cw = B_SMALL + SM_CONVW + layer * 3 * 5632; const float* cb = B_SMALL + SM_CONVB + layer * 5632;
        u32x2 keep[2][4];
#pragma unroll
        for (int n = 0; n < 2; ++n) {
            const int ch = u.pn * 128 + slot + 4 * n;
            f32x4 w0[2], w1[2], w2[2], wb[2];
            w0[0] = *(const f32x4*)(cw + ch); w1[0] = *(const f32x4*)(cw + 2 * DFF + ch); w2[0] = *(const f32x4*)(cw + 4 * DFF + ch); wb[0] = *(const f32x4*)(cb + ch);
            w0[1] = *(const f32x4*)(cw + DFF + ch); w1[1] = *(const f32x4*)(cw + 3 * DFF + ch); w2[1] = *(const f32x4*)(cw + 5 * DFF + ch); wb[1] = *(const f32x4*)(cb + DFF + ch);
#pragma unroll
            for (int ai = 0; ai < 2; ++ai) {
                const int b = 2 * ai + wr;
                f32x4 upe[2], dne[2];
#pragma unroll
                for (int bj = 0; bj < 2; ++bj) {
                    const f32x4 hprev = (b > 0) ? *(const LAS f32x4*)(halo + (1 * 4 + (b > 0 ? b - 1 : 0)) * 256 + bj * 128 + slot + 4 * n) : (f32x4){0.f, 0.f, 0.f, 0.f};
                    const f32x4 hnext = (b < 3) ? *(const LAS f32x4*)(halo + (0 * 4 + (b < 3 ? b + 1 : 3)) * 256 + bj * 128 + slot + 4 * n) : (f32x4){0.f, 0.f, 0.f, 0.f};
#pragma unroll
                    for (int j = 0; j < 4; ++j) {
                        { const float t = dppf<0x121>(acc[ai][bj][3][n][j]); upe[bj][j] = fr > 0 ? t : hprev[j]; }
                        { const float t = dppf<0x12F>(acc[ai][bj][0][n][j]); dne[bj][j] = fr < 15 ? t : hnext[j]; }
                    }
                }
#pragma unroll
                for (int m = 0; m < 4; ++m) {
                    const int lr = ai * 128 + wr * 64 + 4 * fr + m, gr = g0r + lr;
                    f32x4 gv[2];
#pragma unroll
                    for (int bj = 0; bj < 2; ++bj) {
                        f32x4 up = m > 0 ? acc[ai][bj][m > 0 ? m - 1 : 0][n] : upe[bj];
                        f32x4 dn = m < 3 ? acc[ai][bj][m < 3 ? m + 1 : 3][n] : dne[bj];
                        if (hasb) {
                            if (is_seq_start(gr)) up = (f32x4){0.f, 0.f, 0.f, 0.f};
                            if (is_seq_start(gr + 1)) dn = (f32x4){0.f, 0.f, 0.f, 0.f};
                        }
                        gv[bj] = w0[bj] * up + (w1[bj] * acc[ai][bj][m][n] + (w2[bj] * dn + wb[bj]));
                    }
                    const f32x4 g = gv[0], v = gv[1];
                    u32x2 w; w.x = pk2(siluf(g.x) * v.x, siluf(g.y) * v.y); w.y = pk2(siluf(g.z) * v.z, siluf(g.w) * v.w);
                    if (n == 0) { keep[ai][m] = w; asm volatile("" : "+v"(keep[ai][m].x), "+v"(keep[ai][m].y)); }
                    else if (lr >= 1 && lr <= 254 && gr < T) {
                        u32x4 w4; w4.x = keep[ai][m].x; w4.y = keep[ai][m].y; w4.z = w.x; w4.w = w.y;
                        *(u32x4*)(B_ACT + (size_t)gr * DFF + ch - 4) = w4;
                    }
                }
            }
        }
        asm volatile("s_waitcnt lgkmcnt(0)" ::: "memory"); __builtin_amdgcn_s_barrier(); asm volatile("" ::: "memory");
    }
};

__device__ const double ROPE_FREQ[32] = {1.0, 0.7498942093324559, 0.5623413251903491, 0.4216965034285822, 0.31622776601683794, 0.23713737056616552, 0.1778279410038923, 0.1333521432163324,
    0.1, 0.07498942093324558, 0.05623413251903491, 0.042169650342858224, 0.03162277660168379, 0.023713737056616554, 0.01778279410038923, 0.01333521432163324,
    0.01, 0.007498942093324558, 0.005623413251903491, 0.004216965034285823, 0.0031622776601683794, 0.0023713737056616554, 0.0017782794100389228, 0.001333521432163324,
    0.001, 0.0007498942093324559, 0.0005623413251903491, 0.00042169650342858224, 0.00031622776601683794, 0.00023713737056616554, 0.00017782794100389227, 0.0001333521432163324};

DI void p0_item(const float* W, int ldw, int src0, const float* kw, int k0, bf16_t* WT, int K, int dst0, LAS float* scr, int lane) {
#pragma unroll 8
    for (int i = 0; i < 32; ++i) { const int kk = 2 * i + (lane >> 5); float w = W[(size_t)(k0 + kk) * ldw + src0 + (lane & 31)]; if (kw) w *= kw[k0 + kk]; scr[kk * 33 + (lane & 31)] = w; }
    LDS_WAIT();
    const int c = lane & 7;
#pragma unroll
    for (int j = 0; j < 4; ++j) { const int n = (lane >> 3) + 8 * j; const LAS float* s = scr + (8 * c) * 33 + n;
        u32x4 o; o.x = pk2(s[0 * 33], s[1 * 33]); o.y = pk2(s[2 * 33], s[3 * 33]); o.z = pk2(s[4 * 33], s[5 * 33]); o.w = pk2(s[6 * 33], s[7 * 33]);
        *(u32x4*)(WT + (size_t)(dst0 + n) * K + k0 + 8 * c) = o; }
    LDS_WAIT();
}
DI int headsrc(int w) { return 64 * (w & 3) + 32 * (w >> 2); }
DI void p0_row(const float* xrow, bf16_t* orow, float* ssq, int nssq, int lane) {
    const f32x4* xr = (const f32x4*)xrow + lane; f32x4 v[4]; float s = 0.f;
#pragma unroll
    for (int j = 0; j < 4; ++j) { v[j] = xr[64 * j]; s += sumsq4(v[j]); }
    s = wave_sum(s);
    u32x2* o = (u32x2*)orow + lane;
#pragma unroll
    for (int j = 0; j < 4; ++j) { u32x2 w; w.x = pk2(v[j].x, v[j].y); w.y = pk2(v[j].z, v[j].w); o[64 * j] = w; }
    if (lane < nssq) ssq[lane] = lane == 0 ? s : 0.f;
}

template <bool OUT>
DI void gla_item(const bf16_t* QH, const bf16_t* GT, const bf16_t* VT, bf16_t* US, float* DEC, bf16_t* Odst, int bc, int hd, int dir, int vs, int lane) {
    const int c31 = lane & 31, h = lane >> 5;
    bf16x8 Mf[2], If[2], ONE;
#pragma unroll
    for (int s2 = 0; s2 < 2; ++s2)
#pragma unroll
    for (int jj = 0; jj < 8; ++jj) {
        const int tau = 16 * s2 + 8 * (jj >> 2) + 4 * h + (jj & 3);
        const bool mm = dir ? (tau >= c31) : (tau <= c31);
        Mf[s2][jj] = mm ? (short)0x3F80 : (short)0; If[s2][jj] = (tau == c31) ? (short)0x3F80 : (short)0;
    }
#pragma unroll
    for (int jj = 0; jj < 8; ++jj) ONE[jj] = (short)0x3F80;
    const size_t item = (size_t)(((bc * 6 + hd) * 2 + dir) * 4 + vs);
    bf16_t* dump = US + item * 4096 + lane;
    f32x16 S[4]; float dectot[4] = {0.f, 0.f, 0.f, 0.f};
#pragma unroll
    for (int dt = 0; dt < 4; ++dt)
#pragma unroll
    for (int rg = 0; rg < 16; ++rg) S[dt][rg] = OUT ? bf2f((short)dump[(dt * 16 + rg) * 64]) : 0.f;
    const bf16_t* gtb = GT + (size_t)(dir * 768 + hd * 128 + c31) * T;
    const bf16_t* vtb = VT + (size_t)(hd * 128 + vs * 32 + c31) * T;
    f32x16 zero;
#pragma unroll
    for (int rg = 0; rg < 16; ++rg) zero[rg] = 0.f;
    for (int si = 0; si < 8; ++si) {
        const int sub = dir ? 7 - si : si, tok0 = bc * 256 + sub * 32;
        bf16x8 vf[2];
#pragma unroll
        for (int s2 = 0; s2 < 2; ++s2) vf[s2] = ld_frag2(vtb + tok0 + 16 * s2 + 4 * h);
        if (OUT) {
            f32x16 sc = zero; bf16x8 qt[4][2];
#pragma unroll
            for (int dt = 0; dt < 4; ++dt) {
                bf16x8 gf[2];
#pragma unroll
                for (int s2 = 0; s2 < 2; ++s2) gf[s2] = ld_frag2(gtb + (size_t)dt * 32 * T + tok0 + 16 * s2 + 4 * h);
                f32x16 bT = zero, gT = zero;
#pragma unroll
                for (int s2 = 0; s2 < 2; ++s2) { bT = MFMA32(gf[s2], Mf[s2], bT); gT = MFMA32(gf[s2], If[s2], gT); }
                const bf16_t* qp = QH + (size_t)(tok0 + c31) * 768 + hd * 128 + dt * 32 + 4 * h;
#pragma unroll
                for (int s2 = 0; s2 < 2; ++s2) {
                    const bf16x8 qv = ld_frag2(qp + 16 * s2);
                    float qq[8], kk[8];
#pragma unroll
                    for (int jj = 0; jj < 8; ++jj) {
                        const float b = fmaxf(bT[8 * s2 + jj], -80.f), e = ex2(b);
                        qq[jj] = bf2f(qv[jj]) * e;
                        kk[jj] = (1.0f - ex2(gT[8 * s2 + jj])) * ex2(-b);
                    }
                    qt[dt][s2] = mk8(qq[0], qq[1], qq[2], qq[3], qq[4], qq[5], qq[6], qq[7]);
                    const bf16x8 kt = mk8(kk[0], kk[1], kk[2], kk[3], kk[4], kk[5], kk[6], kk[7]);
                    sc = MFMA32(kt, qt[dt][s2], sc);
                }
            }
#pragma unroll
            for (int rg = 0; rg < 16; ++rg) { const int s = crow(rg, h); const bool keep = dir ? (s >= c31) : (s <= c31); sc[rg] = keep ? sc[rg] : 0.f; }
            f32x16 o = zero;
            o = MFMA32(pack8<0>(sc), vf[0], o); o = MFMA32(pack8<1>(sc), vf[1], o);
#pragma unroll
            for (int dt = 0; dt < 4; ++dt) { o = MFMA32(qt[dt][0], pack8<0>(S[dt]), o); o = MFMA32(qt[dt][1], pack8<1>(S[dt]), o); }
            bf16_t* op = Odst + (size_t)tok0 * 768 + hd * 128 + vs * 32 + c31;
#pragma unroll
            for (int rg = 0; rg < 16; ++rg) op[(size_t)crow(rg, h) * 768] = f2bf(o[rg]);
        }
#pragma unroll
        for (int dt = 0; dt < 4; ++dt) {
            bf16x8 gf[2];
#pragma unroll
            for (int s2 = 0; s2 < 2; ++s2) gf[s2] = ld_frag2(gtb + (size_t)dt * 32 * T + tok0 + 16 * s2 + 4 * h);
            f32x16 bD = zero, tD = zero, dr = zero;
#pragma unroll
            for (int s2 = 0; s2 < 2; ++s2) { bD = MFMA32(Mf[s2], gf[s2], bD); tD = MFMA32(ONE, gf[s2], tD); dr = MFMA32(gf[s2], ONE, dr); }
            const float tot = tD[0];
            if (!OUT) dectot[dt] += tot;
#pragma unroll
            for (int rg = 0; rg < 16; ++rg) S[dt][rg] *= ex2(dr[rg]);
            {
                float ke[8];
#pragma unroll
                for (int jj = 0; jj < 8; ++jj) ke[jj] = (1.0f - ex2(bf2f(gf[0][jj]))) * ex2(tot - bD[jj]);
                S[dt] = MFMA32(mk8(ke[0], ke[1], ke[2], ke[3], ke[4], ke[5], ke[6], ke[7]), vf[0], S[dt]);
#pragma unroll
                for (int jj = 0; jj < 8; ++jj) ke[jj] = (1.0f - ex2(bf2f(gf[1][jj]))) * ex2(tot - bD[8 + jj]);
                S[dt] = MFMA32(mk8(ke[0], ke[1], ke[2], ke[3], ke[4], ke[5], ke[6], ke[7]), vf[1], S[dt]);
            }
        }
    }
    if (!OUT) {
#pragma unroll
        for (int dt = 0; dt < 4; ++dt)
#pragma unroll
        for (int rg = 0; rg < 16; ++rg) dump[(dt * 16 + rg) * 64] = f2bf(S[dt][rg]);
        if (vs == 0 && h == 0) {
            float* dp = DEC + (size_t)((bc * 6 + hd) * 2 + dir) * 128 + c31;
#pragma unroll
            for (int dt = 0; dt < 4; ++dt) dp[32 * dt] = dectot[dt];
        }
    }
}

constexpr int GLA_GRP_BYTES = 33 * 1024;
template <bool OUT>
DI void gla_wg(const bf16_t* QH, const bf16_t* GT, const bf16_t* VT, bf16_t* US, float* DEC, bf16_t* OF_, bf16_t* OB_, LAS unsigned char* lds, int wave, int lane) {
    const int c31 = lane & 31, h = lane >> 5, grp = wave >> 2, j = wave & 3, dir = grp;
    bf16x8 Mf[2], If[2], ONE;
#pragma unroll
    for (int s2 = 0; s2 < 2; ++s2)
#pragma unroll
    for (int jj = 0; jj < 8; ++jj) {
        const int tau = 16 * s2 + 8 * (jj >> 2) + 4 * h + (jj & 3);
        const bool mm = dir ? (tau >= c31) : (tau <= c31);
        Mf[s2][jj] = mm ? (short)0x3F80 : (short)0; If[s2][jj] = (tau == c31) ? (short)0x3F80 : (short)0;
    }
#pragma unroll
    for (int jj = 0; jj < 8; ++jj) ONE[jj] = (short)0x3F80;
    f32x16 zero;
#pragma unroll
    for (int rg = 0; rg < 16; ++rg) zero[rg] = 0.f;
    bf16_t* Odst = dir ? OB_ : OF_;
    int par = 0; bool first = true;
    bf16x8 gfn[2], vfn[2], qvn[2];
#pragma unroll
    for (int s2 = 0; s2 < 2; ++s2) { gfn[s2] = ONE; vfn[s2] = ONE; qvn[s2] = ONE; }
    const int G_ = (int)gridDim.x, nfull = 1152 / G_, rem = 1152 % G_, nrounds = nfull + (rem ? 1 : 0);
    const bool split = rem > 0 && rem * 2 == G_;
    for (int rd = 0; rd < nrounds; ++rd) {
        int wi = (int)blockIdx.x + rd * G_; bool active = true;
        if (rd == nfull) { if (split) { wi = nfull * G_ + (int)blockIdx.x % rem; active = (grp == (int)blockIdx.x / rem); } else if (wi >= 1152) break; }
        int wn = -1; bool an = false;
        if (rd + 1 < nrounds) { if (rd + 1 == nfull && split) { wn = nfull * G_ + (int)blockIdx.x % rem; an = (grp == (int)blockIdx.x / rem); } else { wn = (int)blockIdx.x + (rd + 1) * G_; an = wn < 1152; } }
        if (!active) {
            for (int si = 0; si < 8; ++si, par ^= 1) { asm volatile("s_waitcnt lgkmcnt(0)" ::: "memory"); __builtin_amdgcn_s_barrier(); asm volatile("" ::: "memory"); }
            continue;
        }
        const int hd = wi % 6, bc = wi / 6;
        const size_t item = (size_t)(((bc * 6 + hd) * 2 + dir) * 4 + j);
        bf16_t* dump = US + item * 4096 + lane * 64;
        f32x16 S[4]; float dectot = 0.f;
#pragma unroll
        for (int dt = 0; dt < 4; ++dt) {
            if (OUT) {
                const u32x4 lo = *(const u32x4*)(dump + dt * 16), hi = *(const u32x4*)(dump + dt * 16 + 8);
#pragma unroll
                for (int q = 0; q < 4; ++q) { S[dt][2 * q] = __uint_as_float(lo[q] << 16); S[dt][2 * q + 1] = __uint_as_float(lo[q] & 0xffff0000u);
                                              S[dt][8 + 2 * q] = __uint_as_float(hi[q] << 16); S[dt][8 + 2 * q + 1] = __uint_as_float(hi[q] & 0xffff0000u); }
            } else {
#pragma unroll
                for (int rg = 0; rg < 16; ++rg) S[dt][rg] = 0.f;
            }
        }
        const bf16_t* gtb = GT + (size_t)(dir * 768 + hd * 128 + 32 * j + c31) * T;
        const bf16_t* vtb = VT + (size_t)(hd * 128 + 32 * j + c31) * T;
        if (first) {
            const int tokf = bc * 256 + (dir ? 7 : 0) * 32;
#pragma unroll
            for (int s2 = 0; s2 < 2; ++s2) { gfn[s2] = ld_frag2(gtb + tokf + 16 * s2 + 4 * h); vfn[s2] = ld_frag2(vtb + tokf + 16 * s2 + 4 * h);
                if (OUT) qvn[s2] = ld_frag2(QH + (size_t)(tokf + c31) * 768 + hd * 128 + 32 * j + 4 * h + 16 * s2); }
            first = false;
        }
        for (int si = 0; si < 8; ++si, par ^= 1) {
            const int sub = dir ? 7 - si : si, tok0 = bc * 256 + sub * 32;
            bf16x8 gf[2], vf[2], qvv[2];
#pragma unroll
            for (int s2 = 0; s2 < 2; ++s2) { gf[s2] = gfn[s2]; vf[s2] = vfn[s2]; qvv[s2] = qvn[s2]; }
            {
                int bcn = bc, hdn = hd, subn = dir ? 6 - si : si + 1;
                if (si == 7) { if (an) { hdn = wn % 6; bcn = wn / 6; subn = dir ? 7 : 0; } else subn = sub; }
                const int tokn = bcn * 256 + subn * 32;
                const bf16_t* gtn = GT + (size_t)(dir * 768 + hdn * 128 + 32 * j + c31) * T; const bf16_t* vtn = VT + (size_t)(hdn * 128 + 32 * j + c31) * T;
#pragma unroll
                for (int s2 = 0; s2 < 2; ++s2) { gfn[s2] = ld_frag2(gtn + tokn + 16 * s2 + 4 * h); vfn[s2] = ld_frag2(vtn + tokn + 16 * s2 + 4 * h);
                    if (OUT) qvn[s2] = ld_frag2(QH + (size_t)(tokn + c31) * 768 + hdn * 128 + 32 * j + 4 * h + 16 * s2); }
            }
            LAS unsigned char* base = lds + (par * 2 + grp) * GLA_GRP_BYTES;
            LAS bf16x8* QT = (LAS bf16x8*)base; LAS bf16x8* KE = (LAS bf16x8*)(base + 8192); LAS f32x4* SC = (LAS f32x4*)(base + 16384); LAS float* DR = (LAS float*)(base + 32768);
            {
                f32x16 bD = zero, tD = zero;
#pragma unroll
                for (int s2 = 0; s2 < 2; ++s2) { bD = MFMA32(Mf[s2], gf[s2], bD); tD = MFMA32(ONE, gf[s2], tD); }
                const float tot = tD[0];
                dectot += tot;
                if (h == 0) DR[j * 32 + c31] = ex2(tot);
                float ke[8];
#pragma unroll
                for (int jj = 0; jj < 8; ++jj) ke[jj] = (1.0f - ex2(bf2f(gf[0][jj]))) * ex2(tot - bD[jj]);
                KE[(j * 2 + 0) * 64 + lane] = mk8(ke[0], ke[1], ke[2], ke[3], ke[4], ke[5], ke[6], ke[7]);
#pragma unroll
                for (int jj = 0; jj < 8; ++jj) ke[jj] = (1.0f - ex2(bf2f(gf[1][jj]))) * ex2(tot - bD[8 + jj]);
                KE[(j * 2 + 1) * 64 + lane] = mk8(ke[0], ke[1], ke[2], ke[3], ke[4], ke[5], ke[6], ke[7]);
            }
            if (OUT) {
                f32x16 bT = zero, gT = zero, scp = zero;
#pragma unroll
                for (int s2 = 0; s2 < 2; ++s2) { bT = MFMA32(gf[s2], Mf[s2], bT); gT = MFMA32(gf[s2], If[s2], gT); }
#pragma unroll
                for (int s2 = 0; s2 < 2; ++s2) {
                    const bf16x8 qv = qvv[s2];
                    float qq[8], kk[8];
#pragma unroll
                    for (int jj = 0; jj < 8; ++jj) {
                        const float b = fmaxf(bT[8 * s2 + jj], -80.f), e = ex2(b);
                        qq[jj] = bf2f(qv[jj]) * e;
                        kk[jj] = (1.0f - ex2(gT[8 * s2 + jj])) * ex2(-b);
                    }
                    const bf16x8 qt = mk8(qq[0], qq[1], qq[2], qq[3], qq[4], qq[5], qq[6], qq[7]);
                    const bf16x8 kt = mk8(kk[0], kk[1], kk[2], kk[3], kk[4], kk[5], kk[6], kk[7]);
                    QT[(j * 2 + s2) * 64 + lane] = qt;
                    scp = MFMA32(kt, qt, scp);
                }
#pragma unroll
                for (int g4 = 0; g4 < 4; ++g4) SC[(j * 4 + g4) * 64 + lane] = (f32x4){scp[4 * g4], scp[4 * g4 + 1], scp[4 * g4 + 2], scp[4 * g4 + 3]};
            }
            asm volatile("s_waitcnt lgkmcnt(0)" ::: "memory"); __builtin_amdgcn_s_barrier(); asm volatile("" ::: "memory");
            if (OUT) {
                f32x16 sc = zero;
#pragma unroll
                for (int dt = 0; dt < 4; ++dt)
#pragma unroll
                for (int g4 = 0; g4 < 4; ++g4) { const f32x4 t = SC[(dt * 4 + g4) * 64 + lane]; sc[4 * g4] += t.x; sc[4 * g4 + 1] += t.y; sc[4 * g4 + 2] += t.z; sc[4 * g4 + 3] += t.w; }
#pragma unroll
                for (int rg = 0; rg < 16; ++rg) { const int s = crow(rg, h); const bool keep = dir ? (s >= c31) : (s <= c31); sc[rg] = keep ? sc[rg] : 0.f; }
                f32x16 o = zero;
                o = MFMA32(pack8<0>(sc), vf[0], o); o = MFMA32(pack8<1>(sc), vf[1], o);
#pragma unroll
                for (int dt = 0; dt < 4; ++dt) { o = MFMA32(QT[(dt * 2 + 0) * 64 + lane], pack8<0>(S[dt]), o); o = MFMA32(QT[(dt * 2 + 1) * 64 + lane], pack8<1>(S[dt]), o); }
                bf16_t* op = Odst + (size_t)tok0 * 768 + hd * 128 + j * 32 + c31;
#pragma unroll
                for (int rg = 0; rg < 16; ++rg) op[(size_t)crow(rg, h) * 768] = f2bf(o[rg]);
            }
#pragma unroll
            for (int dt = 0; dt < 4; ++dt) {
#pragma unroll
                for (int a = 0; a < 4; ++a) { const f32x4 dv = *(const LAS f32x4*)(DR + dt * 32 + 8 * a + 4 * h); S[dt][4 * a] *= dv.x; S[dt][4 * a + 1] *= dv.y; S[dt][4 * a + 2] *= dv.z; S[dt][4 * a + 3] *= dv.w; }
                S[dt] = MFMA32(KE[(dt * 2 + 0) * 64 + lane], vf[0], S[dt]);
                S[dt] = MFMA32(KE[(dt * 2 + 1) * 64 + lane], vf[1], S[dt]);
            }
        }
        if (!OUT) {
#pragma unroll
            for (int dt = 0; dt < 4; ++dt) {
                u32x4 lo, hi;
#pragma unroll
                for (int q = 0; q < 4; ++q) { lo[q] = pk2(S[dt][2 * q], S[dt][2 * q + 1]); hi[q] = pk2(S[dt][8 + 2 * q], S[dt][8 + 2 * q + 1]); }
                *(u32x4*)(dump + dt * 16) = lo; *(u32x4*)(dump + dt * 16 + 8) = hi;
            }
            if (h == 0) DEC[(size_t)((bc * 6 + hd) * 2 + dir) * 128 + 32 * j + c31] = dectot;
        }
    }
    __syncthreads();
}

DI void gla_scan_item(bf16_t* US, const float* DEC, int chain, int part, int lane) {
    const int vs = chain & 3, dir = (chain >> 2) & 1, hs = chain >> 3, hd = hs % 6, sq = hs / 6;
    const int bc0 = sq < 4 ? 16 * sq : 64 + 64 * (sq - 4), nbc = sq < 4 ? 16 : 64;
    const int L = part * 8 + (lane >> 3), kk = lane & 7, dt = kk >> 1, q = kk & 1, hh = L >> 5;
    const int d0 = 32 * dt + 16 * q + 4 * hh;
    float carry[8];
#pragma unroll
    for (int i = 0; i < 8; ++i) carry[i] = 0.f;
    u32x4 un[4]; f32x4 dan[4], dbn[4];
#pragma unroll
    for (int k = 0; k < 4; ++k) {
        const int bc = bc0 + (dir ? nbc - 1 - k : k);
        const size_t item = (size_t)(((bc * 6 + hd) * 2 + dir) * 4 + vs);
        un[k] = *(const u32x4*)(US + item * 4096 + part * 512 + lane * 8);
        const float* dp = DEC + (size_t)((bc * 6 + hd) * 2 + dir) * 128 + d0;
        dan[k] = *(const f32x4*)dp; dbn[k] = *(const f32x4*)(dp + 8);
    }
    for (int n0 = 0; n0 < nbc; n0 += 4) {
        u32x4 u[4]; f32x4 dla[4], dlb[4];
#pragma unroll
        for (int k = 0; k < 4; ++k) { u[k] = un[k]; dla[k] = dan[k]; dlb[k] = dbn[k]; }
        if (n0 + 4 < nbc) {
#pragma unroll
            for (int k = 0; k < 4; ++k) {
                const int n = n0 + 4 + k, bc = bc0 + (dir ? nbc - 1 - n : n);
                const size_t item = (size_t)(((bc * 6 + hd) * 2 + dir) * 4 + vs);
                un[k] = *(const u32x4*)(US + item * 4096 + part * 512 + lane * 8);
                const float* dp = DEC + (size_t)((bc * 6 + hd) * 2 + dir) * 128 + d0;
                dan[k] = *(const f32x4*)dp; dbn[k] = *(const f32x4*)(dp + 8);
            }
        }
#pragma unroll
        for (int k = 0; k < 4; ++k) {
            const int n = n0 + k, bc = bc0 + (dir ? nbc - 1 - n : n);
            const size_t item = (size_t)(((bc * 6 + hd) * 2 + dir) * 4 + vs);
            u32x4 w; w.x = pk2(carry[0], carry[1]); w.y = pk2(carry[2], carry[3]); w.z = pk2(carry[4], carry[5]); w.w = pk2(carry[6], carry[7]);
            *(u32x4*)(US + item * 4096 + part * 512 + lane * 8) = w;
#pragma unroll
            for (int i = 0; i < 4; ++i) {
                const unsigned x = u[k][i];
                const float de = ex2(i < 2 ? dla[k][2 * i] : dlb[k][2 * (i - 2)]), dod = ex2(i < 2 ? dla[k][2 * i + 1] : dlb[k][2 * (i - 2) + 1]);
                carry[2 * i] = de * carry[2 * i] + __uint_as_float(x << 16);
                carry[2 * i + 1] = dod * carry[2 * i + 1] + __uint_as_float(x & 0xffff0000u);
            }
        }
    }
}

template <bool WIN>
DI void attn_item(const bf16_t* qrow  , const bf16_t* kbase  , int ldk, const bf16_t* vtbase  , size_t ldvt,
                  int q0, int key_lo, int ntiles, int kvalid_lo, int kvalid_hi, float mref, float l0, bf16_t* orow  , int lane) {
    const int c31 = lane & 31, h = lane >> 5;
    bf16x8 qf[4];
#pragma unroll
    for (int s = 0; s < 4; ++s) qf[s] = *(const bf16x8*)(qrow + 16 * s + 8 * h);
    f32x16 O[2];
#pragma unroll
    for (int rg = 0; rg < 16; ++rg) { O[0][rg] = 0.f; O[1][rg] = 0.f; }
    float lrun = (h == 0) ? l0 : 0.f;
    int tlo = 0, thi = ntiles;
    if (WIN) { tlo = kvalid_lo > key_lo ? (kvalid_lo - key_lo) >> 5 : 0; const int e = (kvalid_hi - key_lo) >> 5; thi = e < ntiles ? e : ntiles; }
    for (int ti = tlo; ti < thi; ++ti) {
        const int k0 = key_lo + 32 * ti;
        const bf16_t* kr = kbase + (size_t)(k0 + c31) * ldk + 8 * h;
        f32x16 sc;
#pragma unroll
        for (int rg = 0; rg < 16; ++rg) sc[rg] = -mref;
#pragma unroll
        for (int s = 0; s < 4; ++s) { const bf16x8 kf = *(const bf16x8*)(kr + 16 * s); sc = MFMA32(kf, qf[s], sc); }
        if (WIN && (ti == 0 || ti == ntiles - 1)) {
#pragma unroll
            for (int rg = 0; rg < 16; ++rg) { const int df = (k0 + crow(rg, h)) - (q0 + c31); sc[rg] = (df >= -128 && df <= 128) ? sc[rg] : -1e30f; }
        }
        float ps = 0.f;
#pragma unroll
        for (int rg = 0; rg < 16; ++rg) { sc[rg] = ex2(sc[rg]); ps += sc[rg]; }
        lrun += ps;
        const bf16x8 p0 = pack8<0>(sc), p1 = pack8<1>(sc);
#pragma unroll
        for (int t = 0; t < 2; ++t) {
            const bf16_t* vp = vtbase + (size_t)(32 * t + c31) * ldvt + k0 + 4 * h;
            O[t] = MFMA32(ld_frag2(vp), p0, O[t]);
            O[t] = MFMA32(ld_frag2(vp + 16), p1, O[t]);
        }
    }
    const float linv = rcpf(lrun + __shfl_xor(lrun, 32));
#pragma unroll
    for (int t = 0; t < 2; ++t)
#pragma unroll
    for (int g = 0; g < 4; ++g) {
        u32x2 w; w.x = pk2(O[t][4 * g] * linv, O[t][4 * g + 1] * linv); w.y = pk2(O[t][4 * g + 2] * linv, O[t][4 * g + 3] * linv);
        *(u32x2*)(orow + 32 * t + 8 * g + 4 * h) = w;
    }
}

constexpr int KSTR = 144;
template <bool WIN, int VSTR>
DI void attn_wave_lds(const bf16_t* qrow, const LAS unsigned char* Kl, const LAS unsigned char* Vl, int tlo, int thi, int edge_lo, int edge_hi, int q_local  ,
                      float mref, float l0, bf16_t* orow, int lane) {
    const int c31 = lane & 31, h = lane >> 5;
    bf16x8 qf[4];
#pragma unroll
    for (int s = 0; s < 4; ++s) qf[s] = *(const bf16x8*)(qrow + 16 * s + 8 * h);
    f32x16 O[2];
#pragma unroll
    for (int rg = 0; rg < 16; ++rg) { O[0][rg] = 0.f; O[1][rg] = 0.f; }
    float lrun = (h == 0) ? l0 : 0.f;
#pragma nounroll
    for (int tl = tlo; tl < thi; ++tl) {
        const LAS unsigned char* kr = Kl + (32 * tl + c31) * KSTR + 16 * h;
        f32x16 sc;
#pragma unroll
        for (int rg = 0; rg < 16; ++rg) sc[rg] = -mref;
#pragma unroll
        for (int s = 0; s < 4; ++s) { const bf16x8 kf = *(const LAS bf16x8*)(kr + 32 * s); sc = MFMA32(kf, qf[s], sc); }
        if (WIN && (tl == edge_lo || tl == edge_hi)) {
#pragma unroll
            for (int rg = 0; rg < 16; ++rg) { const int df = (32 * tl + crow(rg, h)) - (q_local + c31); sc[rg] = (df >= -128 && df <= 128) ? sc[rg] : -1e30f; }
        }
        float ps = 0.f;
#pragma unroll
        for (int rg = 0; rg < 16; ++rg) { sc[rg] = ex2(sc[rg]); ps += sc[rg]; }
        lrun += ps;
        const bf16x8 p0 = pack8<0>(sc), p1 = pack8<1>(sc);
#pragma unroll
        for (int t = 0; t < 2; ++t) {
            const LAS unsigned char* vp = Vl + (32 * t + c31) * VSTR + 2 * (32 * tl + 4 * h);
            const s16x4 a0 = *(const LAS s16x4*)(vp), a1 = *(const LAS s16x4*)(vp + 16), b0 = *(const LAS s16x4*)(vp + 32), b1 = *(const LAS s16x4*)(vp + 48);
            O[t] = MFMA32(__builtin_shufflevector(a0, a1, 0, 1, 2, 3, 4, 5, 6, 7), p0, O[t]);
            O[t] = MFMA32(__builtin_shufflevector(b0, b1, 0, 1, 2, 3, 4, 5, 6, 7), p1, O[t]);
        }
    }
    const float linv = rcpf(lrun + __shfl_xor(lrun, 32));
#pragma unroll
    for (int t = 0; t < 2; ++t)
#pragma unroll
    for (int g = 0; g < 4; ++g) {
        u32x2 w; w.x = pk2(O[t][4 * g] * linv, O[t][4 * g + 1] * linv); w.y = pk2(O[t][4 * g + 2] * linv, O[t][4 * g + 3] * linv);
        *(u32x2*)(orow + 32 * t + 8 * g + 4 * h) = w;
    }
}
DI void cross_attn_wg(const bf16_t* XQ, const bf16_t* MKl, const bf16_t* MVTl, bf16_t* MIXA, float mref, LAS unsigned char* lds, int tid, int wave, int lane) {
    constexpr int VS = 520;
    LAS unsigned char* Kl = lds; LAS unsigned char* Vl = lds + 256 * KSTR;
    const int vb_ = (gridDim.x & 7) ? (int)blockIdx.x : (int)((blockIdx.x & 7) * (gridDim.x >> 3) + (blockIdx.x >> 3));
    for (int it = vb_; it < 192 * 4; it += gridDim.x) {
        const int qb = it % 192, hx = it / 192, sq = seq_of(qb * 256);
        asm volatile("s_waitcnt lgkmcnt(0)" ::: "memory"); __builtin_amdgcn_s_barrier(); asm volatile("" ::: "memory");
#pragma unroll
        for (int i = 0; i < 4; ++i) { const int id = tid + 512 * i, row = id >> 3, ch = id & 7;
            *(LAS u32x4*)(Kl + row * KSTR + 16 * ch) = *(const u32x4*)(MKl + ((size_t)sq * 256 + row) * 256 + 64 * hx + 8 * ch); }
#pragma unroll
        for (int i = 0; i < 4; ++i) { const int id = tid + 512 * i, row = id >> 5, ch = id & 31;
            const u32x4 v = *(const u32x4*)(MVTl + ((size_t)sq * 256 + 64 * hx + row) * 256 + 8 * ch);
            *(LAS u32x2*)(Vl + row * VS + 16 * ch) = (u32x2){v.x, v.y}; *(LAS u32x2*)(Vl + row * VS + 16 * ch + 8) = (u32x2){v.z, v.w}; }
        asm volatile("s_waitcnt lgkmcnt(0)" ::: "memory"); __builtin_amdgcn_s_barrier(); asm volatile("" ::: "memory");
        const int q0 = qb * 256 + 32 * wave, c31 = lane & 31;
        attn_wave_lds<false, VS>(XQ + (size_t)(q0 + c31) * 256 + 64 * hx, Kl, Vl, 0, 8, -1, -1, 0, mref, 0.f, MIXA + (size_t)(q0 + c31) * D + MIX + 64 * hx, lane);
    }
    __syncthreads();
}
DI void win_attn_wg(const bf16_t* Q1, const bf16_t* K1, const bf16_t* VT1, const float* sm, bf16_t* MIXA, LAS unsigned char* lds, int tid, int wave, int lane) {
    constexpr int VS = 1032;
    LAS unsigned char* Kl = lds; LAS unsigned char* Vl = lds + 512 * KSTR;
    const int vb_ = (gridDim.x & 7) ? (int)blockIdx.x : (int)((blockIdx.x & 7) * (gridDim.x >> 3) + (blockIdx.x >> 3));
    for (int it = vb_; it < 192 * 4; it += gridDim.x) {
        const int qb = it % 192, kvh = it / 192, q0b = qb * 256, key0 = q0b - 128, s0 = seq_start(q0b), s1 = seq_end(q0b);
        asm volatile("s_waitcnt lgkmcnt(0)" ::: "memory"); __builtin_amdgcn_s_barrier(); asm volatile("" ::: "memory");
#pragma unroll 4
        for (int i = 0; i < 8; ++i) { const int id = tid + 512 * i, row = id >> 3, ch = id & 7, key = key0 + row;
            if (key >= s0 && key < s1) *(LAS u32x4*)(Kl + row * KSTR + 16 * ch) = *(const u32x4*)(K1 + (size_t)key * 256 + 64 * kvh + 8 * ch); }
#pragma unroll 4
        for (int i = 0; i < 8; ++i) { const int id = tid + 512 * i, row = id >> 6, ch = id & 63, key = key0 + 8 * ch;
            if (key >= s0 && key < s1) { const u32x4 v = *(const u32x4*)(VT1 + (size_t)(64 * kvh + row) * T + key);
                *(LAS u32x2*)(Vl + row * VS + 16 * ch) = (u32x2){v.x, v.y}; *(LAS u32x2*)(Vl + row * VS + 16 * ch + 8) = (u32x2){v.z, v.w}; } }
        asm volatile("s_waitcnt lgkmcnt(0)" ::: "memory"); __builtin_amdgcn_s_barrier(); asm volatile("" ::: "memory");
        const int q0 = q0b + 32 * wave, c31 = lane & 31;
        int tlo = wave, thi = wave + 9;
        { const int lo = (s0 - key0) >> 5; if (s0 > key0 && lo > tlo) tlo = lo; const int hi = (s1 - key0) >> 5; if (hi < thi) thi = hi; }
#pragma unroll 1
        for (int g = 0; g < 3; ++g) {
            const int qh = 3 * kvh + g; const float sk2 = sm[SM_SINK + qh] * LOG2E, mrefw = fmaxf(sm[SM_BND + 2], sk2);
            attn_wave_lds<true, VS>(Q1 + (size_t)(q0 + c31) * 768 + 64 * qh, Kl, Vl, tlo, thi, wave, wave + 8, 128 + 32 * wave, mrefw, ex2(sk2 - mrefw), MIXA + (size_t)(q0 + c31) * D + 64 * qh, lane);
        }
    }
    __syncthreads();
}

DI void cross_attn_items(const bf16_t* XQ, const bf16_t* MKl, const bf16_t* MVTl, bf16_t* MIXA, float mref, int gw, int NGW, int lane) {
    for (int it = gw; it < 1536 * 4; it += NGW) {
        const int qt = it >> 2, hx = it & 3, q0 = qt * 32, sq = seq_of(q0), c31 = lane & 31;
        attn_item<false>(XQ + (size_t)(q0 + c31) * 256 + 64 * hx, MKl + (size_t)sq * 256 * 256 + 64 * hx, 256, MVTl + ((size_t)sq * 256 + 64 * hx) * 256, 256,
                         q0, 0, 8, 0, 256, mref, 0.f, MIXA + (size_t)(q0 + c31) * D + MIX + 64 * hx, lane);
    }
}

#define KPRE \
    int tid_ = threadIdx.x; asm volatile("" : "+v"(tid_)); const int tid = tid_, lane = tid & 63, wave = __builtin_amdgcn_readfirstlane(tid >> 6); \
    const int G = gridDim.x, gw = wave * G + blockIdx.x, NGW = G * 8; (void)lane; (void)gw; (void)NGW; (void)G; (void)tid;

DI void b_p0(const Params& P, LAS unsigned char* lds) {
    KPRE
    unsigned char* ws = P.ws;
    {
        LAS float* scr = (LAS float*)(lds + wave * 16384);
        for (int it = gw; it < 12800; it += NGW) {
            int r = it;
            if (r < 2048) { const int kb = r >> 7, g = r & 127; const int src = g < 120 ? 32 * g : 3840 + headsrc(g - 120);
                p0_item(P.hg_w_in, 4096, src, P.norm_mix, 64 * kb, B_WHG, 1024, 32 * g, scr, lane); continue; } r -= 2048;
            if (r < 768) { const int kb = r / 48, g = r % 48; const int src = 256 * (g >> 3) + headsrc(g & 7);
                p0_item(P.gq_w_in, 1536, src, P.norm_mix + 1024, 64 * kb, B_WGQ, 1024, 32 * g, scr, lane); continue; } r -= 768;
            if (r < 512) { const int kb = r >> 5, g = r & 31, pn = g >> 3, layer = pn >> 1, kv = pn & 1; const int src = 256 * kv + headsrc(g & 7);
                p0_item(P.x_w_kv + (size_t)layer * 1024 * 512, 512, src, P.norm_mem + 1024 * layer, 64 * kb, B_WKV, 1024, 32 * g, scr, lane); continue; } r -= 512;
            if (r < 1024) { const int l = r >> 9, q = r & 511, kb = q >> 5, g = q & 31;
                p0_item(P.w_out + (size_t)l * 1024 * 1024, 1024, 32 * g, nullptr, 64 * kb, B_WOUT + (size_t)l * 1024 * 1024, 1024, 32 * g, scr, lane); continue; } r -= 1024;
            if (r < 5632) { const int l = r / 2816, q = r % 2816, kb = q / 176, g = q % 176, pn = g >> 3, w = g & 7; const int src = (w >> 2) * DFF + 128 * pn + 32 * (w & 3);
                p0_item(P.ffn_w_up + (size_t)l * 1024 * 5632, 5632, src, P.norm_ffn + 1024 * l, 64 * kb, B_WUP + (size_t)l * 5632 * 1024, 1024, 32 * g, scr, lane); continue; } r -= 5632;
            { const int l = r / 1408, q = r % 1408, kb = q >> 5, g = q & 31;
                p0_item(P.ffn_w_down + (size_t)l * DFF * 1024, 1024, 32 * g, nullptr, 64 * kb, B_WDN + (size_t)l * 1024 * DFF, DFF, 32 * g, scr, lane); }
        }
        for (int m = gw; m < T + MROWS; m += NGW) {
            if (m < T) p0_row(m < TP ? P.x_prompt + (size_t)m * D : P.x_sample + (size_t)(m - TP) * D, B_XB + (size_t)m * D, B_SSQ + (size_t)m * 4, 4, lane);
            else { const int q = m - T; p0_row(q < 1024 ? P.mem_prompt + (size_t)q * D : P.mem_sample + (size_t)(q - 1024) * D, B_MEMB + (size_t)q * D, B_SSQM + (size_t)q * 4, 4, lane); }
        }
        for (int i = blockIdx.x * 512 + tid; i < 16384 * 32; i += G * 512) {
            const int pos = i >> 5, f = i & 31;
            const double rev = (double)pos * ROPE_FREQ[f] * 0.15915494309189535;
            const float fr = (float)(rev - __builtin_rint(rev));
            B_ROPEC[i] = __builtin_amdgcn_cosf(fr); B_ROPES[i] = __builtin_amdgcn_sinf(fr);
        }
        for (int i = blockIdx.x * 512 + tid; i < SM_END; i += G * 512) {
            float v = 0.f;
            if (i < SM_XKN) v = P.x_qn[i];
            else if (i < SM_GQQN) v = P.x_kn[i - SM_XKN];
            else if (i < SM_GQKN) v = P.gq_qn[i - SM_GQQN];
            else if (i < SM_SINK) v = P.gq_kn[i - SM_GQKN];
            else if (i < SM_SINK + 12) v = P.gq_sink[i - SM_SINK];
            else if (i >= SM_BND && i < SM_BND + 3) {
                const float* wq = i == SM_BND + 2 ? P.gq_qn : P.x_qn + 64 * (i - SM_BND); const float* wk = i == SM_BND + 2 ? P.gq_kn : P.x_kn + 64 * (i - SM_BND);
                float mq = 0.f, mk = 0.f;
                for (int e = 0; e < 64; ++e) { mq = fmaxf(mq, fabsf(wq[e])); mk = fmaxf(mk, fabsf(wk[e])); }
                v = 8.0f * LOG2E * mq * mk;
            }
            else if (i >= SM_HGGN && i < SM_HGGN + 768) v = P.hg_gn[i - SM_HGGN];
            else if (i >= SM_CONVW && i < SM_CONVW + 2 * 3 * 5632) v = P.ffn_conv_w[i - SM_CONVW];
            else if (i >= SM_CONVB && i < SM_CONVB + 2 * 5632) v = P.ffn_conv_b[i - SM_CONVB];
            B_SMALL[i] = v;
        }
        for (int i = blockIdx.x * 512 + tid; i < 2 * 768; i += G * 512) {
            const int dir = i / 768, c = i % 768; const float* p = P.hg_lb + (size_t)dir * 3 * 768 + c;
            const float a = p[0], b = p[768], cc = p[1536], mx = fmaxf(a, fmaxf(b, cc));
            const float ea = __expf(a - mx), eb = __expf(b - mx), ec = __expf(cc - mx);
            B_LB[i] = ea / (ea + eb + ec);
        }
    }

}

struct GArgs { unsigned char* ws; float* out; const float* resP; const float* resS; int layer, write_aux, sub, pad; };
template <int KIND>
DI void b_gemm(GArgs a, LAS unsigned char* lds) {
    unsigned char* ws = a.ws;
    const int G = gridDim.x;
    pg8::Gemm g; int nM = 192, nN = 4;
    EpiAll<KIND> E{ws, a.out, a.resP, a.resS, (LAS float*)(lds + HALO_OFF), a.layer, a.write_aux};
    g.M = T; g.N = 1024; g.K = 1024; g.rs = 256; g.r0 = 0;
    if (KIND == EK_KV) { g.A = B_MEMB; g.Bt = B_WKV; nM = 6; nN = 4; }
    else if (KIND == EK_HG) { g.A = B_XB; g.Bt = B_WHG; nN = 16; }
    else if (KIND == EK_GQ) { g.A = B_XB; g.Bt = B_WGQ; nN = 6; }
    else if (KIND == EK_UP) { g.A = B_XB; g.Bt = B_WUP + (size_t)a.layer * 5632 * 1024; nM = NUP_TILES; nN = 22; g.rs = 254; g.r0 = -1; }
    else if (a.sub == 0) { g.A = B_MIXA; g.Bt = B_WOUT + (size_t)a.layer * 1024 * 1024; }
    else { g.A = B_ACT; g.Bt = B_WDN + (size_t)a.layer * 1024 * DFF; g.K = DFF; }
    pg8::StaticOrder S; S.init(nM, nN, G, (int)blockIdx.x);
    S.rev = (KIND == EK_UP || KIND == EK_GQ) ? 1 : 0;
    pg8::gemm_phase<EpiAll<KIND>, pg8::StaticOrder, PG8_ALIGN, PG8_SP2>(lds, g, S, E);
}

template <bool OUT>
DI void b_gla(unsigned char* ws, float* out, LAS unsigned char* lds) {
    KPRE
    gla_wg<OUT>(B_QH, B_GT, B_VT, B_US, B_DEC, B_OF, B_OB, lds, wave, lane);
}
DI void b_scan(unsigned char* ws) {
    KPRE
    const int G2 = G - 24, gw2 = wave * G2 + ((int)blockIdx.x - 24);
    const int W_ = G2 * 8, n2 = 288 * 8 - W_;
    if (n2 <= W_ - 768 || n2 <= 0) {
        if (gw2 < 288 * 8) { const int it2 = gw2 < 768 ? gw2 + 1536 : gw2 - 768; gla_scan_item(B_US, B_DEC, it2 >> 3, it2 & 7, lane); }
        if (n2 > 0 && gw2 >= 768 && gw2 < 768 + n2) { const int it = W_ + gw2 - 768; const int it2 = it - 768; gla_scan_item(B_US, B_DEC, it2 >> 3, it2 & 7, lane); }
    } else {
        for (int it = gw2; it < 288 * 8; it += W_) { const int it2 = it < 768 ? it + 1536 : it - 768; gla_scan_item(B_US, B_DEC, it2 >> 3, it2 & 7, lane); }
    }
}
template <int LAYER>
DI void b_mix(unsigned char* ws, float* out, LAS unsigned char* lds) {
    KPRE
    if (LAYER == 0) {
        for (int r = gw; r < T; r += NGW) {
            const bf16_t* of = B_OF + (size_t)r * 768; const bf16_t* ob = B_OB + (size_t)r * 768; const bf16_t* go = r < 32768 ? B_GO1 + (size_t)r * 768 : B_GO2 + (size_t)(r - 32768) * 768;
            float o[12]; float ss = 0.f;
    #pragma unroll
            for (int j = 0; j < 3; ++j) {
                const u32x2 a = *(const u32x2*)(of + 256 * j + 4 * lane), b = *(const u32x2*)(ob + 256 * j + 4 * lane);
                o[4 * j] = __uint_as_float(a.x << 16) + __uint_as_float(b.x << 16); o[4 * j + 1] = __uint_as_float(a.x & 0xffff0000u) + __uint_as_float(b.x & 0xffff0000u);
                o[4 * j + 2] = __uint_as_float(a.y << 16) + __uint_as_float(b.y << 16); o[4 * j + 3] = __uint_as_float(a.y & 0xffff0000u) + __uint_as_float(b.y & 0xffff0000u);
    #pragma unroll
                for (int i = 0; i < 4; ++i) ss += o[4 * j + i] * o[4 * j + i];
            }
            ss = wave_sum(ss);
            const float rn = __builtin_amdgcn_rsqf(ss * (1.0f / 768.0f) + EPS);
    #pragma unroll
            for (int j = 0; j < 3; ++j) {
                const u32x2 gv = *(const u32x2*)(go + 256 * j + 4 * lane); const f32x4 gn = *(const f32x4*)(B_SMALL + SM_HGGN + 256 * j + 4 * lane);
                u32x2 w; w.x = pk2(o[4 * j] * rn * gn.x * siluf(__uint_as_float(gv.x << 16)), o[4 * j + 1] * rn * gn.y * siluf(__uint_as_float(gv.x & 0xffff0000u)));
                w.y = pk2(o[4 * j + 2] * rn * gn.z * siluf(__uint_as_float(gv.y << 16)), o[4 * j + 3] * rn * gn.w * siluf(__uint_as_float(gv.y & 0xffff0000u)));
                *(u32x2*)(B_MIXA + (size_t)r * D + 256 * j + 4 * lane) = w;
            }
        }


    } else {
        win_attn_wg(B_Q1, B_K1, B_VT1, B_SMALL, B_MIXA, lds, tid, wave, lane);
    }
    cross_attn_wg(B_XQ, B_MK + (size_t)LAYER * MROWS * 256, B_MVT + (size_t)LAYER * 6 * 256 * 256, B_MIXA, B_SMALL[SM_BND + LAYER], lds, tid, wave, lane);
}

#define OPQ() size_t zo_ = 0; asm volatile("" : "+s"(zo_)); unsigned char* ws = P.ws + zo_; float* out = (float*)((unsigned char*)P.out + zo_);
DI void gbar(unsigned char* wsb, unsigned k) {
    __syncthreads();
    if (threadIdx.x == 0) {
        unsigned* base = (unsigned*)(wsb + WS_END);
        const unsigned grp = blockIdx.x & 7u, ngrp = gridDim.x < 8u ? gridDim.x : 8u, gsz = (gridDim.x - grp + 7u) >> 3;
        __builtin_amdgcn_fence(__ATOMIC_RELEASE, "agent");
        const unsigned a = __hip_atomic_fetch_add(base + 64 * grp, 1u, __ATOMIC_RELAXED, __HIP_MEMORY_SCOPE_AGENT);
        if (a + 1u == k * gsz) {
            const unsigned b = __hip_atomic_fetch_add(base + 64 * 8, 1u, __ATOMIC_RELAXED, __HIP_MEMORY_SCOPE_AGENT);
            if (b + 1u == k * ngrp) __hip_atomic_store(base + 64 * 9, k, __ATOMIC_RELAXED, __HIP_MEMORY_SCOPE_AGENT);
        }
        while (__hip_atomic_load(base + 64 * 9, __ATOMIC_RELAXED, __HIP_MEMORY_SCOPE_AGENT) < k) __builtin_amdgcn_s_sleep(1);
        __builtin_amdgcn_fence(__ATOMIC_ACQUIRE, "agent");
    }
    __syncthreads();
}
__global__ void __launch_bounds__(512, 2) mega_fwd(Params P) {
    extern __shared__ __attribute__((aligned(16))) unsigned char lds_raw[];
    cg::grid_group grid = cg::this_grid();
    LAS unsigned char* lds = (LAS unsigned char*)lds_raw;
    if (blockIdx.x == 0 && threadIdx.x < 10) __hip_atomic_store((unsigned*)(P.ws + WS_END) + 64 * threadIdx.x, 0u, __ATOMIC_RELAXED, __HIP_MEMORY_SCOPE_AGENT);
    b_p0(P, lds);
    __syncthreads();
    grid.sync();
    { OPQ(); GArgs a{ws, out, out, out + (size_t)TP * D, 0, 1, 0, 0}; b_gemm<EK_HG>(a, lds); }
    gbar(P.ws, 1u);
    { OPQ(); b_gla<false>(ws, out, lds); }
    gbar(P.ws, 2u);
    if (blockIdx.x < 24) { OPQ(); GArgs a{ws, out, out, out + (size_t)TP * D, 0, 1, 0, 0}; b_gemm<EK_KV>(a, lds); }
    else { OPQ(); b_scan(ws); }
    gbar(P.ws, 3u);
    { OPQ(); b_gla<true>(ws, out, lds); }
    gbar(P.ws, 4u);
    { OPQ(); b_mix<0>(ws, out, lds); }
    gbar(P.ws, 5u);
    { OPQ(); GArgs a{ws, out, P.x_prompt, P.x_sample, 0, 1, 0, 0}; b_gemm<EK_RES>(a, lds); }
    gbar(P.ws, 6u);
    { OPQ(); GArgs a{ws, out, out, out + (size_t)TP * D, 0, 1, 1, 0}; b_gemm<EK_UP>(a, lds); }
    gbar(P.ws, 7u);
    { OPQ(); GArgs a{ws, out, out, out + (size_t)TP * D, 0, 1, 2, 0}; b_gemm<EK_RES>(a, lds); }
    gbar(P.ws, 8u);
    { OPQ(); GArgs a{ws, out, out, out + (size_t)TP * D, 1, 1, 0, 0}; b_gemm<EK_GQ>(a, lds); }
    gbar(P.ws, 9u);
    { OPQ(); b_mix<1>(ws, out, lds); }
    gbar(P.ws, 10u);
    { OPQ(); GArgs a{ws, out, out, out + (size_t)TP * D, 1, 1, 0, 0}; b_gemm<EK_RES>(a, lds); }
    gbar(P.ws, 11u);
    { OPQ(); GArgs a{ws, out, out, out + (size_t)TP * D, 1, 1, 1, 0}; b_gemm<EK_UP>(a, lds); }
    gbar(P.ws, 12u);
    { OPQ(); GArgs a{ws, out, out, out + (size_t)TP * D, 1, 0, 2, 0}; b_gemm<EK_RES>(a, lds); }
}

extern "C" void kernel_launch(void* const* d_in, const int* in_sizes, int n_in, void* d_out, int out_size, void* d_ws, size_t ws_size, hipStream_t stream) {
    static int grid = 0;
    if (grid == 0) {
        if (n_in != 22 || ws_size < WS_END + 4096) { fprintf(stderr, "kernel_launch: unexpected n_in %d or ws_size %zu (< %zu)\n", n_in, ws_size, (size_t)WS_END); grid = -1; return; }
        int dev = 0, cus = 0, per_cu = 0;
        (void)hipGetDevice(&dev); (void)hipDeviceGetAttribute(&cus, hipDeviceAttributeMultiprocessorCount, dev);
        if (hipFuncSetAttribute((const void*)mega_fwd, hipFuncAttributeMaxDynamicSharedMemorySize, LDS_BYTES) != hipSuccess) { fprintf(stderr, "kernel_launch: hipFuncSetAttribute failed\n"); grid = -1; return; }
        if (hipOccupancyMaxActiveBlocksPerMultiprocessor(&per_cu, (const void*)mega_fwd, 512, LDS_BYTES) != hipSuccess || per_cu < 1) { fprintf(stderr, "kernel_launch: occupancy query gave %d\n", per_cu); per_cu = 1; }
        (void)hipGetLastError();
        grid = (cus > 0 ? cus : 256) * 1;
    }
    if (grid < 0) return;
    Params p{};
    const float** pp = (const float**)&p;
    for (int i = 0; i < 22; ++i) pp[i] = (const float*)d_in[i];
    p.out = (float*)d_out; p.ws = (unsigned char*)d_ws;
    void* args[] = {&p};
    hipError_t e = hipLaunchCooperativeKernel((const void*)mega_fwd, dim3(grid), dim3(512), args, LDS_BYTES, stream);
    if (e != hipSuccess) fprintf(stderr, "cooperative launch failed: %s (grid %d)\n", hipGetErrorString(e), grid);
}
```
